# Optimizing an MI355X kernel written in HIP

```python
import math
import jax, jax.numpy as jnp
from jax import lax
import numpy as np

D_MODEL = 1024
BATCH = 2
SEQ = 8192
DEPTH = 1

HG_HEADS = 4
HG_KDIM = 128
HG_VDIM = 128
HG_WIDTH = HG_HEADS * HG_VDIM
HG_FDIM = HG_HEADS * HG_KDIM
HG_CHUNK = 64
ATT_HEADS = 4
ATT_HEAD_DIM = 128
ATT_WIDTH = ATT_HEADS * ATT_HEAD_DIM
IDX_HEADS = 8
IDX_DIM = 64
INDEX_TOPK_MAX = 256
QUERY_BLOCK = 128
D_MIX = HG_WIDTH + ATT_WIDTH
ROPE_THETA = 500000.0
ROPE_FRACTION = 4
D_FF = -(-8 * D_MODEL // (3 * 256)) * 256
N_MOD = 6
EPS = 1e-6

IN_SIZES = (HG_FDIM, HG_FDIM, HG_WIDTH, HG_WIDTH,
            ATT_WIDTH, ATT_WIDTH, ATT_WIDTH,
            IDX_HEADS * IDX_DIM, IDX_DIM, IDX_HEADS)
D_IN = sum(IN_SIZES)

kernel_name = "hymba_hgrn2_dsa_block"


def rmsnorm(x, gain):
    xf = x.astype(jnp.float32)
    y = xf * lax.rsqrt(jnp.mean(xf * xf, axis=-1, keepdims=True) + EPS)
    return (y * gain.astype(jnp.float32)).astype(x.dtype)


def layernorm(x, w, b):
    xf = x.astype(jnp.float32)
    mu = jnp.mean(xf, axis=-1, keepdims=True)
    var = jnp.mean(jnp.square(xf - mu), axis=-1, keepdims=True)
    y = (xf - mu) * lax.rsqrt(var + EPS)
    return (y * w.astype(jnp.float32) + b.astype(jnp.float32)).astype(x.dtype)


def partial_rope(x, positions):
    d = x.shape[-1]
    rot = d // ROPE_FRACTION
    half = rot // 2
    inv_freq = ROPE_THETA ** (-jnp.arange(half, dtype=jnp.float32) / half)
    ang = positions.astype(jnp.float32)[..., None] * inv_freq
    cos = jnp.cos(ang)[:, :, None, :]
    sin = jnp.sin(ang)[:, :, None, :]
    xf = x.astype(jnp.float32)
    x1, x2, xp = xf[..., :half], xf[..., half:rot], xf[..., rot:]
    out = jnp.concatenate([x1 * cos - x2 * sin, x2 * cos + x1 * sin, xp], axis=-1)
    return out.astype(x.dtype)


def hgrn2_mixer(q, f_raw, i, g_out, lower_bound, out_norm):
    B, T, _ = q.shape
    nc = T // HG_CHUNK
    dt = q.dtype
    qf = jax.nn.silu(q.astype(jnp.float32)) * HG_KDIM ** -0.5
    f = lower_bound + (1.0 - lower_bound) * jax.nn.sigmoid(f_raw.astype(jnp.float32))
    k = 1.0 - f
    logf = jnp.log(f)

    def chunks(a, d):
        return a.reshape(B, nc, HG_CHUNK, HG_HEADS, d).transpose(1, 0, 3, 2, 4)

    qc, kc = chunks(qf, HG_KDIM), chunks(k, HG_KDIM)
    gc = jnp.cumsum(chunks(logf, HG_KDIM), axis=3)
    vc = chunks(i.astype(jnp.float32), HG_VDIM)
    causal = jnp.tril(jnp.ones((HG_CHUNK, HG_CHUNK), dtype=bool))

    def step(S, inp):
        qb, kb, vb, gb = inp
        o_inter = jnp.einsum('bhtk,bhkv->bhtv', qb * jnp.exp(gb), S)
        diff = gb[:, :, :, None, :] - gb[:, :, None, :, :]
        decay = jnp.exp(jnp.where(causal[None, None, :, :, None], diff, -jnp.inf))
        A = jnp.einsum('bhtk,bhsk,bhtsk->bhts', qb, kb, decay)
        o_intra = jnp.einsum('bhts,bhsv->bhtv', A, vb)
        g_last = gb[:, :, -1]
        S_new = jnp.exp(g_last)[..., None] * S + jnp.einsum(
            'bhsk,bhsv->bhkv', kb * jnp.exp(g_last[:, :, None, :] - gb), vb)
        return S_new, o_inter + o_intra

    S0 = jnp.zeros((B, HG_HEADS, HG_KDIM, HG_VDIM), jnp.float32)
    _, o = lax.scan(step, S0, (qc, kc, vc, gc))
    o = o.transpose(1, 0, 3, 2, 4).reshape(B, T, HG_HEADS, HG_VDIM)
    o = o * lax.rsqrt(jnp.mean(o * o, axis=-1, keepdims=True) + EPS)
    o = o * out_norm.astype(jnp.float32).reshape(HG_HEADS, HG_VDIM)
    o = o.reshape(B, T, HG_WIDTH) * jax.nn.silu(g_out.astype(jnp.float32))
    return o.astype(dt)


def dsa_mixer(q, k, v, q_idx, k_idx, w_idx, positions, k_norm_w, k_norm_b):
    B, T, _ = q.shape
    topk = min(INDEX_TOPK_MAX, T // 4)
    nb = T // QUERY_BLOCK
    q = partial_rope(q.reshape(B, T, ATT_HEADS, ATT_HEAD_DIM), positions)
    k = partial_rope(k.reshape(B, T, ATT_HEADS, ATT_HEAD_DIM), positions)
    v = v.reshape(B, T, ATT_HEADS, ATT_HEAD_DIM)
    q_idx = partial_rope(q_idx.reshape(B, T, IDX_HEADS, IDX_DIM), positions)
    k_idx = layernorm(k_idx, k_norm_w, k_norm_b)
    k_idx = partial_rope(k_idx[:, :, None, :], positions)[:, :, 0, :]
    w_idx = w_idx * (IDX_HEADS ** -0.5 * IDX_DIM ** -0.5)
    key_pos = jnp.arange(T, dtype=jnp.int32)
    gather = jax.vmap(lambda a, ix: a[ix])
    scale = ATT_HEAD_DIM ** -0.5

    def to_blocks(a):
        return a.reshape(B, nb, QUERY_BLOCK, *a.shape[2:]).swapaxes(0, 1)

    def block(args):
        qi, wi, qb, tq = args
        s = jnp.einsum('bqhd,bsd->bqhs', qi, k_idx)
        score = jnp.einsum('bqh,bqhs->bqs', wi, jax.nn.relu(s)).astype(jnp.float32)
        score = jnp.where(key_pos[None, None, :] <= tq[None, :, None], score, -jnp.inf)
        _, idx = lax.top_k(score, topk)
        valid = idx <= tq[None, :, None]
        ks = gather(k, idx)
        vs = gather(v, idx)
        logits = jnp.einsum('bqhd,bqkhd->bhqk', qb, ks).astype(jnp.float32) * scale
        logits = jnp.where(valid[:, None], logits, -jnp.inf)
        p = jax.nn.softmax(logits, axis=-1).astype(vs.dtype)
        return jnp.einsum('bhqk,bqkhd->bqhd', p, vs)

    o = lax.map(block, (to_blocks(q_idx), to_blocks(w_idx), to_blocks(q),
                        key_pos.reshape(nb, QUERY_BLOCK)))
    return o.swapaxes(0, 1).reshape(B, T, ATT_WIDTH)


def setup_inputs(seed: int = 0) -> dict:
    key = jax.random.key(seed)
    ks = jax.random.split(key, 20)
    nrm = lambda k, shape, s: jax.random.normal(k, shape, jnp.float32) * s
    gain = lambda k, shape: 1.0 + 0.02 * jax.random.normal(k, shape, jnp.float32)
    x = nrm(ks[0], (BATCH, SEQ, D_MODEL), 1.0)
    c = nrm(ks[1], (BATCH, D_MODEL), 1.0)
    positions = (jnp.arange(SEQ, dtype=jnp.int32)[None, :]
                 + jax.random.randint(ks[2], (BATCH, 1), 0, 4096, dtype=jnp.int32))
    return {
        "x": x,
        "c": c,
        "positions": positions,
        "w_ada": nrm(ks[3], (DEPTH, D_MODEL, N_MOD * D_MODEL), 0.5 * D_MODEL ** -0.5),
        "b_ada": nrm(ks[4], (DEPTH, N_MOD * D_MODEL), 0.01),
        "norm_pre_mix": gain(ks[5], (DEPTH, D_MODEL)),
        "norm_post_mix": gain(ks[6], (DEPTH, D_MODEL)),
        "norm_pre_ffn": gain(ks[7], (DEPTH, D_MODEL)),
        "norm_post_ffn": gain(ks[8], (DEPTH, D_MODEL)),
        "w_in": nrm(ks[9], (DEPTH, D_MODEL, D_IN), D_MODEL ** -0.5),
        "hgrn_lower_bound": nrm(ks[10], (DEPTH + 1, HG_FDIM), 1.0),
        "hgrn_out_norm": gain(ks[11], (DEPTH, HG_WIDTH)),
        "idx_k_norm_w": gain(ks[12], (DEPTH, IDX_DIM)),
        "idx_k_norm_b": nrm(ks[13], (DEPTH, IDX_DIM), 0.02),
        "w_out": nrm(ks[14], (DEPTH, D_MIX, D_MODEL), D_MIX ** -0.5),
        "w_ffn_in": nrm(ks[15], (DEPTH, D_MODEL, 2 * D_FF), D_MODEL ** -0.5),
        "w_ffn_out": nrm(ks[16], (DEPTH, D_FF, D_MODEL), D_FF ** -0.5),
    }


def reference(x, c, positions, w_ada, b_ada, norm_pre_mix, norm_post_mix, norm_pre_ffn,
              norm_post_ffn, w_in, hgrn_lower_bound, hgrn_out_norm, idx_k_norm_w, idx_k_norm_b,
              w_out, w_ffn_in, w_ffn_out):
    split_points = np.cumsum(IN_SIZES)[:-1].tolist()
    lb_all = jnp.cumsum(jax.nn.softmax(hgrn_lower_bound.astype(jnp.float32), axis=0), axis=0)
    for layer in range(DEPTH):
        mod = jax.nn.silu(c) @ w_ada[layer] + b_ada[layer]
        sh_m, sc_m, gt_m, sh_f, sc_f, gt_f = [m[:, None, :] for m in jnp.split(mod, N_MOD, axis=-1)]

        h = rmsnorm(x, norm_pre_mix[layer]) * (1.0 + sc_m) + sh_m
        proj = h @ w_in[layer]
        (hq, hf, hi, hg, aq, ak, av, iq, ik, iw) = jnp.split(proj, split_points, axis=-1)
        o_hg = hgrn2_mixer(hq, hf, hi, hg, lb_all[layer], hgrn_out_norm[layer])
        o_att = dsa_mixer(aq, ak, av, iq, ik, iw, positions,
                          idx_k_norm_w[layer], idx_k_norm_b[layer])
        y = jnp.concatenate([o_hg, o_att], axis=-1) @ w_out[layer]
        x = x + gt_m * rmsnorm(y, norm_post_mix[layer])

        h = rmsnorm(x, norm_pre_ffn[layer]) * (1.0 + sc_f) + sh_f
        gate, up = jnp.split(h @ w_ffn_in[layer], 2, axis=-1)
        y = (jax.nn.silu(gate) * up) @ w_ffn_out[layer]
        x = x + gt_f * rmsnorm(y, norm_post_ffn[layer])
    return x
```

```cpp
#include <hip/hip_runtime.h>
#include <hip/hip_fp16.h>
#include <cstdio>
#include <cstdint>

namespace {
constexpr int B_ = 2, T_ = 8192, D_ = 1024, M_ = B_ * T_;
constexpr int DIN = 4168, DFF = 2816;
constexpr float EPS = 1e-6f;

__constant__ float c_inv16[16] = {1.f, 0.440366596f, 0.193922743f, 0.0853971019f, 0.0376060307f, 0.0165604409f, 0.00729266461f, 0.00321144611f,
                                  0.00141421356f, 0.000622772437f, 0.000274248188f, 0.000120769735f, 5.31829573e-05f, 2.34199997e-05f, 1.03133852e-05f, 4.54167048e-06f};
__constant__ float c_inv8[8] = {1.f, 0.193922743f, 0.0376060307f, 0.00729266461f, 0.00141421356f, 0.000274248188f, 5.31829573e-05f, 1.03133852e-05f};

__device__ __forceinline__ float wave_sum(float v) {
#pragma unroll
    for (int o = 1; o < 64; o <<= 1) v += __shfl_xor(v, o);
    return v;
}
__device__ __forceinline__ float wave_max(float v) {
#pragma unroll
    for (int o = 1; o < 64; o <<= 1) v = fmaxf(v, __shfl_xor(v, o));
    return v;
}
__device__ __forceinline__ float sigmoidf_(float v) { return 1.f / (1.f + expf(-v)); }
__device__ __forceinline__ float siluf_(float v) { return v / (1.f + expf(-v)); }

__device__ __forceinline__ void sincos_acc(float ang, float& s, float& c) {
    const double a = (double)ang;
    const double n = rint(a * 0.63661977236758134308);
    double y = fma(-n, 1.57079632679489655800, a);
    y = fma(-n, 6.12323399573676603587e-17, y);
    const int q = (int)((long long)n & 3);
    const double y2 = y * y;
    const double sp = y * (1.0 + y2 * (-1.0 / 6.0 + y2 * (1.0 / 120.0 + y2 * (-1.0 / 5040.0 + y2 * (1.0 / 362880.0 + y2 * (-1.0 / 39916800.0 + y2 * (1.0 / 6227020800.0 + y2 * (-1.0 / 1307674368000.0))))))));
    const double cp = 1.0 + y2 * (-0.5 + y2 * (1.0 / 24.0 + y2 * (-1.0 / 720.0 + y2 * (1.0 / 40320.0 + y2 * (-1.0 / 3628800.0 + y2 * (1.0 / 479001600.0 + y2 * (-1.0 / 87178291200.0)))))));
    double sd, cd;
    if (q == 0) { sd = sp; cd = cp; } else if (q == 1) { sd = cp; cd = -sp; } else if (q == 2) { sd = -sp; cd = -cp; } else { sd = -cp; cd = sp; }
    s = (float)sd; c = (float)cd;
}

__global__ __launch_bounds__(256) void mod_kernel(const float* __restrict__ c, const float* __restrict__ w_ada, const float* __restrict__ b_ada,
                                                  const float* __restrict__ lbraw, float* __restrict__ mod, float* __restrict__ lb) {
    __shared__ float sc[2][1024];
    for (int i = threadIdx.x; i < 2048; i += 256) { const float v = c[i]; sc[i >> 10][i & 1023] = siluf_(v); }
    __syncthreads();
    const int j = blockIdx.x * 256 + threadIdx.x;
    float a0 = 0.f, a1 = 0.f;
    for (int d = 0; d < 1024; ++d) { const float w = w_ada[(size_t)d * 6144 + j]; a0 = fmaf(sc[0][d], w, a0); a1 = fmaf(sc[1][d], w, a1); }
    mod[j] = a0 + b_ada[j]; mod[6144 + j] = a1 + b_ada[j];
    if (blockIdx.x == 0) for (int i = threadIdx.x; i < 512; i += 256) lb[i] = 1.f / (1.f + expf(lbraw[512 + i] - lbraw[i]));
}

__global__ __launch_bounds__(256) void normmod_kernel(const float* __restrict__ x, const float* __restrict__ gain, const float* __restrict__ mod, int sc_off, int sh_off, __half* __restrict__ H) {
    const int wave = threadIdx.x >> 6, lane = threadIdx.x & 63, m = blockIdx.x * 4 + wave, b = m / T_;
    const float4* xr = (const float4*)(x + (size_t)m * D_);
    float4 v[4]; float ss = 0.f;
#pragma unroll
    for (int j = 0; j < 4; ++j) { v[j] = xr[lane + 64 * j]; ss += v[j].x * v[j].x + v[j].y * v[j].y + v[j].z * v[j].z + v[j].w * v[j].w; }
    const float r = rsqrtf(wave_sum(ss) * (1.f / D_) + EPS);
    const float* mb = mod + b * 6144;
#pragma unroll
    for (int j = 0; j < 4; ++j) {
        const int col = (lane + 64 * j) * 4;
        const float vv[4] = {v[j].x, v[j].y, v[j].z, v[j].w};
#pragma unroll
        for (int e = 0; e < 4; ++e) { const int cc = col + e; H[(size_t)m * D_ + cc] = __float2half(vv[e] * r * gain[cc] * (1.f + mb[sc_off + cc]) + mb[sh_off + cc]); }
    }
}

template <class Epi, bool DUAL>
__global__ __launch_bounds__(256) void gemm_naive(const __half* __restrict__ A, const float* __restrict__ W, int N, int K, int ldw, int dual_off, Epi epi) {
    __shared__ __attribute__((aligned(16))) float As[16][68];
    __shared__ __attribute__((aligned(16))) float Bs[16][68];
    __shared__ __attribute__((aligned(16))) float Bs2[DUAL ? 16 : 1][68];
    const int tid = threadIdx.x, tx = tid & 15, ty = tid >> 4;
    const int row0 = blockIdx.y * 64, col0 = blockIdx.x * 64;
    float acc[4][4], acc2[4][4];
#pragma unroll
    for (int i = 0; i < 4; ++i)
#pragma unroll
        for (int j = 0; j < 4; ++j) { acc[i][j] = 0.f; acc2[i][j] = 0.f; }
    const int ar = tid >> 2, ak = (tid & 3) * 4;
    const int bk = tid >> 4, bc = (tid & 15) * 4;
    for (int k0 = 0; k0 < K; k0 += 16) {
        {
            const __half* ap = A + (size_t)(row0 + ar) * K + k0 + ak;
#pragma unroll
            for (int i = 0; i < 4; ++i) As[ak + i][ar] = __half2float(ap[i]);
            const float* wp = W + (size_t)(k0 + bk) * ldw + col0 + bc;
#pragma unroll
            for (int i = 0; i < 4; ++i) {
                Bs[bk][bc + i] = (col0 + bc + i < N) ? wp[i] : 0.f;
                if (DUAL) Bs2[bk][bc + i] = (col0 + bc + i < N) ? wp[dual_off + i] : 0.f;
            }
        }
        __syncthreads();
#pragma unroll
        for (int kk = 0; kk < 16; ++kk) {
            const float4 a = *(const float4*)&As[kk][ty * 4];
            const float4 b = *(const float4*)&Bs[kk][tx * 4];
            const float av[4] = {a.x, a.y, a.z, a.w}, bv[4] = {b.x, b.y, b.z, b.w};
#pragma unroll
            for (int i = 0; i < 4; ++i)
#pragma unroll
                for (int j = 0; j < 4; ++j) acc[i][j] = fmaf(av[i], bv[j], acc[i][j]);
            if (DUAL) {
                const float4 b2 = *(const float4*)&Bs2[kk][tx * 4];
                const float b2v[4] = {b2.x, b2.y, b2.z, b2.w};
#pragma unroll
                for (int i = 0; i < 4; ++i)
#pragma unroll
                    for (int j = 0; j < 4; ++j) acc2[i][j] = fmaf(av[i], b2v[j], acc2[i][j]);
            }
        }
        __syncthreads();
    }
#pragma unroll
    for (int i = 0; i < 4; ++i)
#pragma unroll
        for (int j = 0; j < 4; ++j) { const int col = col0 + tx * 4 + j; if (col < N) epi(row0 + ty * 4 + i, col, acc[i][j], acc2[i][j]); }
}

struct EpiIn {
    __half *QH, *LF, *V, *G, *AQ, *AK, *AV, *IQ; float* IKRAW; float* IW; const float* lb;
    __device__ __forceinline__ void operator()(int row, int col, float v, float) const {
        const int g = col >> 9, j = col & 511; const size_t o = (size_t)row * 512 + j;
        if (g == 0) QH[o] = __float2half(siluf_(v) * 0.08838834764831845f);
        else if (g == 1) { const float l = lb[j]; const float f = l + (1.f - l) * sigmoidf_(v); LF[o] = __float2half(logf(f)); }
        else if (g == 2) V[o] = __float2half(v);
        else if (g == 3) G[o] = __float2half(siluf_(v));
        else if (g == 4) AQ[o] = __float2half(v * 0.08838834764831845f);
        else if (g == 5) AK[o] = __float2half(v);
        else if (g == 6) AV[o] = __float2half(v);
        else if (g == 7) IQ[o] = __float2half(v);
        else if (col < 4160) IKRAW[(size_t)row * 64 + (col - 4096)] = v;
        else IW[(size_t)row * 8 + (col - 4160)] = v * 0.04419417382415922f;
    }
};
struct EpiF32 { float* Y; int ldc; __device__ __forceinline__ void operator()(int row, int col, float v, float) const { Y[(size_t)row * ldc + col] = v; } };
struct EpiSwiGLU { __half* ACT; __device__ __forceinline__ void operator()(int row, int col, float g, float u) const { ACT[(size_t)row * DFF + col] = __float2half(siluf_(g) * u); } };

__global__ __launch_bounds__(256) void fixup_kernel(const int* __restrict__ positions, __half* AQ, __half* AK, __half* IQ, const float* __restrict__ IKRAW, __half* __restrict__ IK,
                                                    const float* __restrict__ knw, const float* __restrict__ knb) {
    const int wave = threadIdx.x >> 6, lane = threadIdx.x & 63, m = blockIdx.x * 4 + wave;
    const float pos = (float)positions[m];
    float s_, c_;
    {
        const float inv = lane < 16 ? c_inv16[lane] : c_inv8[lane & 7];
        sincos_acc(pos * inv, s_, c_);
    }
    {
        const int h = lane >> 4, i = lane & 15;
        const float cs = __shfl(c_, i), sn = __shfl(s_, i);
        const size_t o = (size_t)m * 512 + h * 128 + i;
        { const float x1 = __half2float(AQ[o]), x2 = __half2float(AQ[o + 16]); AQ[o] = __float2half(x1 * cs - x2 * sn); AQ[o + 16] = __float2half(x2 * cs + x1 * sn); }
        { const float x1 = __half2float(AK[o]), x2 = __half2float(AK[o + 16]); AK[o] = __float2half(x1 * cs - x2 * sn); AK[o + 16] = __float2half(x2 * cs + x1 * sn); }
    }
    {
        const int h = lane >> 3, i = lane & 7;
        const float cs = __shfl(c_, 16 + i), sn = __shfl(s_, 16 + i);
        const size_t o = (size_t)m * 512 + h * 64 + i;
        const float x1 = __half2float(IQ[o]), x2 = __half2float(IQ[o + 8]); IQ[o] = __float2half(x1 * cs - x2 * sn); IQ[o + 8] = __float2half(x2 * cs + x1 * sn);
    }
    {
        const float v = IKRAW[(size_t)m * 64 + lane];
        const float mu = wave_sum(v) * (1.f / 64.f);
        const float d = v - mu;
        const float var = wave_sum(d * d) * (1.f / 64.f);
        float y = d * rsqrtf(var + EPS) * knw[lane] + knb[lane];
        const float other = __shfl_xor(y, 8);
        const float cs = __shfl(c_, 16 + (lane & 7)), sn = __shfl(s_, 16 + (lane & 7));
        if (lane < 8) y = y * cs - other * sn; else if (lane < 16) y = y * cs + other * sn;
        IK[(size_t)m * 64 + lane] = __float2half(y);
    }
}

__global__ __launch_bounds__(64) void hgrn_naive(const __half* __restrict__ QH, const __half* __restrict__ LF, const __half* __restrict__ V, float* __restrict__ OH) {
    const int bh = blockIdx.x >> 1, b = bh >> 2, h = bh & 3, lane = threadIdx.x, j = (blockIdx.x & 1) * 64 + lane;
    float S[128];
#pragma unroll
    for (int k = 0; k < 128; ++k) S[k] = 0.f;
    for (int t = 0; t < T_; ++t) {
        const size_t row = (size_t)(b * T_ + t) * 512 + h * 128;
        const float v = __half2float(V[row + j]);
        const float f0 = expf(__half2float(LF[row + lane])), f1 = expf(__half2float(LF[row + 64 + lane]));
        const float q0 = __half2float(QH[row + lane]), q1 = __half2float(QH[row + 64 + lane]);
        float o = 0.f;
#pragma unroll
        for (int k = 0; k < 64; ++k) {
            const float f = __int_as_float(__builtin_amdgcn_readlane(__float_as_int(f0), k)), q = __int_as_float(__builtin_amdgcn_readlane(__float_as_int(q0), k));
            S[k] = fmaf(f, S[k] - v, v); o = fmaf(q, S[k], o);
        }
#pragma unroll
        for (int k = 0; k < 64; ++k) {
            const float f = __int_as_float(__builtin_amdgcn_readlane(__float_as_int(f1), k)), q = __int_as_float(__builtin_amdgcn_readlane(__float_as_int(q1), k));
            S[64 + k] = fmaf(f, S[64 + k] - v, v); o = fmaf(q, S[64 + k], o);
        }
        OH[row + j] = o;
    }
}
__global__ __launch_bounds__(256) void hgrn_post(const float* __restrict__ OH, const __half* __restrict__ G, const float* __restrict__ onorm, __half* __restrict__ OM) {
    const int wave = threadIdx.x >> 6, lane = threadIdx.x & 63, idx = blockIdx.x * 4 + wave, m = idx >> 2, h = idx & 3;
    const size_t o = (size_t)m * 512 + h * 128;
    const float a = OH[o + lane], b = OH[o + 64 + lane];
    const float r = rsqrtf(wave_sum(a * a + b * b) * (1.f / 128.f) + EPS);
    OM[(size_t)m * 1024 + h * 128 + lane] = __float2half(a * r * onorm[h * 128 + lane] * __half2float(G[o + lane]));
    OM[(size_t)m * 1024 + h * 128 + 64 + lane] = __float2half(b * r * onorm[h * 128 + 64 + lane] * __half2float(G[o + 64 + lane]));
}

__device__ __forceinline__ unsigned tokey(float f) { const unsigned u = __float_as_uint(f); return (u & 0x80000000u) ? ~u : (u | 0x80000000u); }
#define SCI(s) ((s) + ((s) >> 5))
__global__ __launch_bounds__(256) void dsa_naive(const __half* __restrict__ IQ, const __half* __restrict__ IK, const float* __restrict__ IW,
                                                 const __half* __restrict__ AQ, const __half* __restrict__ AK, const __half* __restrict__ AV, __half* __restrict__ OM) {
    __shared__ float sc[8192 + 256];
    __shared__ float qi[512];
    __shared__ float qa[512];
    __shared__ float wv[8];
    __shared__ unsigned hist[256];
    __shared__ int sel[256];
    __shared__ int cnt_gt[256], cnt_eq[256];
    __shared__ float lg[4][256];
    __shared__ unsigned sh_prefix; __shared__ int sh_remaining;
    const int m = (M_ - 1) - blockIdx.x;
    const int b = m / T_, t = m % T_, n = t + 1, tid = threadIdx.x;
    for (int i = tid; i < 512; i += 256) { qi[i] = __half2float(IQ[(size_t)m * 512 + i]); qa[i] = __half2float(AQ[(size_t)m * 512 + i]); }
    if (tid < 8) wv[tid] = IW[(size_t)m * 8 + tid];
    __syncthreads();
    for (int s = tid; s < n; s += 256) {
        const uint4* kr = (const uint4*)(IK + (size_t)(b * T_ + s) * 64);
        float kf[64];
#pragma unroll
        for (int i = 0; i < 8; ++i) {
            const uint4 u = kr[i];
            const unsigned w[4] = {u.x, u.y, u.z, u.w};
#pragma unroll
            for (int e = 0; e < 4; ++e) { kf[i * 8 + e * 2] = __half2float(__ushort_as_half((unsigned short)(w[e] & 0xffff))); kf[i * 8 + e * 2 + 1] = __half2float(__ushort_as_half((unsigned short)(w[e] >> 16))); }
        }
        float score = 0.f;
#pragma unroll
        for (int h = 0; h < 8; ++h) {
            float d = 0.f;
#pragma unroll
            for (int e = 0; e < 64; ++e) d = fmaf(qi[h * 64 + e], kf[e], d);
            score = fmaf(wv[h], fmaxf(d, 0.f), score);
        }
        if (score == 0.f) score = 0.f;
        sc[SCI(s)] = score;
    }
    __syncthreads();
    int nsel;
    if (n <= 256) {
        if (tid < n) sel[tid] = tid;
        nsel = n;
    } else {
        unsigned prefix = 0; int remaining = 256;
        for (int pass = 0; pass < 4; ++pass) {
            const int shift = 24 - 8 * pass;
            hist[tid] = 0u;
            __syncthreads();
            for (int i = 0; i < 32; ++i) {
                const int s = tid * 32 + i;
                if (s < n) {
                    const unsigned key = tokey(sc[SCI(s)]);
                    if (pass == 0 || (unsigned)((unsigned long long)key >> (shift + 8)) == prefix) atomicAdd(&hist[(key >> shift) & 255u], 1u);
                }
            }
            __syncthreads();
            if (tid == 0) {
                int cum = 0, bin = 255;
                for (; bin > 0; --bin) { const int c = (int)hist[bin]; if (cum + c >= remaining) break; cum += c; }
                sh_prefix = (prefix << 8) | (unsigned)bin; sh_remaining = remaining - cum;
            }
            __syncthreads();
            prefix = sh_prefix; remaining = sh_remaining;
        }
        const unsigned thr = prefix;
        int cg = 0, ce = 0;
        for (int i = 0; i < 32; ++i) { const int s = tid * 32 + i; if (s < n) { const unsigned key = tokey(sc[SCI(s)]); cg += key > thr; ce += key == thr; } }
        cnt_gt[tid] = cg; cnt_eq[tid] = ce;
        __syncthreads();
        if (tid == 0) { int a = 0, e = 0; for (int i = 0; i < 256; ++i) { const int g0 = cnt_gt[i], e0 = cnt_eq[i]; cnt_gt[i] = a; cnt_eq[i] = e; a += g0; e += e0; } }
        __syncthreads();
        int pg = cnt_gt[tid], pe = cnt_eq[tid];
        const int ngt = 256 - remaining;
        for (int i = 0; i < 32; ++i) {
            const int s = tid * 32 + i;
            if (s < n) {
                const unsigned key = tokey(sc[SCI(s)]);
                if (key > thr) { if (pg < 256) sel[pg] = s; ++pg; }
                else if (key == thr) { if (pe < remaining) sel[ngt + pe] = s; ++pe; }
            }
        }
        nsel = 256;
    }
    __syncthreads();
    if (tid < nsel) {
        const uint4* kr = (const uint4*)(AK + (size_t)(b * T_ + sel[tid]) * 512);
#pragma unroll 1
        for (int h = 0; h < 4; ++h) {
            float d = 0.f;
#pragma unroll 4
            for (int i = 0; i < 16; ++i) {
                const uint4 u = kr[h * 16 + i];
                const unsigned w[4] = {u.x, u.y, u.z, u.w};
#pragma unroll
                for (int e = 0; e < 4; ++e) {
                    d = fmaf(qa[h * 128 + i * 8 + e * 2], __half2float(__ushort_as_half((unsigned short)(w[e] & 0xffff))), d);
                    d = fmaf(qa[h * 128 + i * 8 + e * 2 + 1], __half2float(__ushort_as_half((unsigned short)(w[e] >> 16))), d);
                }
            }
            lg[h][tid] = d;
        }
    } else {
#pragma unroll
        for (int h = 0; h < 4; ++h) lg[h][tid] = -INFINITY;
    }
    __syncthreads();
    {
        const int w = tid >> 6, lane = tid & 63;
        float l[4]; float mx = -INFINITY;
#pragma unroll
        for (int i = 0; i < 4; ++i) { l[i] = lg[w][lane + 64 * i]; mx = fmaxf(mx, l[i]); }
        mx = wave_max(mx);
        float sum = 0.f;
#pragma unroll
        for (int i = 0; i < 4; ++i) { l[i] = (lane + 64 * i < nsel) ? expf(l[i] - mx) : 0.f; sum += l[i]; }
        sum = wave_sum(sum);
        const float inv = 1.f / sum;
#pragma unroll
        for (int i = 0; i < 4; ++i) lg[w][lane + 64 * i] = l[i] * inv;
    }
    __syncthreads();
    {
        const int c0 = tid, c1 = tid + 256, h0 = c0 >> 7, h1 = c1 >> 7;
        float o0 = 0.f, o1 = 0.f;
        for (int j = 0; j < nsel; ++j) {
            const __half* vr = AV + (size_t)(b * T_ + sel[j]) * 512;
            o0 = fmaf(lg[h0][j], __half2float(vr[c0]), o0);
            o1 = fmaf(lg[h1][j], __half2float(vr[c1]), o1);
        }
        OM[(size_t)m * 1024 + 512 + c0] = __float2half(o0);
        OM[(size_t)m * 1024 + 512 + c1] = __float2half(o1);
    }
}

template <bool NEXT>
__global__ __launch_bounds__(256) void post_kernel(const float* xin, const float* __restrict__ Y, const float* __restrict__ g_post, const float* __restrict__ mod, int gt_off,
                                                   float* xout, const float* __restrict__ g_pre, int sc_off, int sh_off, __half* __restrict__ H) {
    const int wave = threadIdx.x >> 6, lane = threadIdx.x & 63, m = blockIdx.x * 4 + wave, b = m / T_;
    const float4* yr = (const float4*)(Y + (size_t)m * D_);
    const float4* xr = (const float4*)(xin + (size_t)m * D_);
    float4* xo = (float4*)(xout + (size_t)m * D_);
    const float* mb = mod + b * 6144;
    float4 y[4], xv[4]; float ss = 0.f;
#pragma unroll
    for (int j = 0; j < 4; ++j) { y[j] = yr[lane + 64 * j]; xv[j] = xr[lane + 64 * j]; ss += y[j].x * y[j].x + y[j].y * y[j].y + y[j].z * y[j].z + y[j].w * y[j].w; }
    const float r = rsqrtf(wave_sum(ss) * (1.f / D_) + EPS);
    float s2 = 0.f;
#pragma unroll
    for (int j = 0; j < 4; ++j) {
        const int col = (lane + 64 * j) * 4;
        xv[j].x += mb[gt_off + col + 0] * (y[j].x * r * g_post[col + 0]);
        xv[j].y += mb[gt_off + col + 1] * (y[j].y * r * g_post[col + 1]);
        xv[j].z += mb[gt_off + col + 2] * (y[j].z * r * g_post[col + 2]);
        xv[j].w += mb[gt_off + col + 3] * (y[j].w * r * g_post[col + 3]);
        xo[lane + 64 * j] = xv[j];
        s2 += xv[j].x * xv[j].x + xv[j].y * xv[j].y + xv[j].z * xv[j].z + xv[j].w * xv[j].w;
    }
    if (NEXT) {
        const float r2 = rsqrtf(wave_sum(s2) * (1.f / D_) + EPS);
#pragma unroll
        for (int j = 0; j < 4; ++j) {
            const int col = (lane + 64 * j) * 4;
            const float vv[4] = {xv[j].x, xv[j].y, xv[j].z, xv[j].w};
#pragma unroll
            for (int e = 0; e < 4; ++e) { const int cc = col + e; H[(size_t)m * D_ + cc] = __float2half(vv[e] * r2 * g_pre[cc] * (1.f + mb[sc_off + cc]) + mb[sh_off + cc]); }
        }
    }
}
}

extern "C" void kernel_launch(void* const* d_in, const int* in_sizes, int n_in, void* d_out, int out_size, void* d_ws, size_t ws_size, hipStream_t stream) {
    const float* x = (const float*)d_in[0]; const float* c = (const float*)d_in[1]; const int* positions = (const int*)d_in[2];
    const float* w_ada = (const float*)d_in[3]; const float* b_ada = (const float*)d_in[4];
    const float* n_pre_mix = (const float*)d_in[5]; const float* n_post_mix = (const float*)d_in[6]; const float* n_pre_ffn = (const float*)d_in[7]; const float* n_post_ffn = (const float*)d_in[8];
    const float* w_in = (const float*)d_in[9]; const float* lbraw = (const float*)d_in[10]; const float* onorm = (const float*)d_in[11];
    const float* knw = (const float*)d_in[12]; const float* knb = (const float*)d_in[13];
    const float* w_out = (const float*)d_in[14]; const float* w_ffn_in = (const float*)d_in[15]; const float* w_ffn_out = (const float*)d_in[16];
    float* out = (float*)d_out;
    unsigned char* ws = (unsigned char*)d_ws;
    constexpr size_t MiB = 1u << 20;
    if (ws_size < 232 * MiB || n_in != 17) { fprintf(stderr, "kernel_launch: unexpected ws_size %zu / n_in %d\n", ws_size, n_in); return; }
    float* MOD = (float*)(ws + 0); float* LB = (float*)(ws + 64 * 1024);
    __half* H = (__half*)(ws + 1 * MiB);
    __half* QH = (__half*)(ws + 33 * MiB); __half* LF = (__half*)(ws + 49 * MiB); __half* V = (__half*)(ws + 65 * MiB); __half* G = (__half*)(ws + 81 * MiB);
    __half* AQ = (__half*)(ws + 97 * MiB); __half* AK = (__half*)(ws + 113 * MiB); __half* AV = (__half*)(ws + 129 * MiB); __half* IQ = (__half*)(ws + 145 * MiB);
    __half* IK = (__half*)(ws + 161 * MiB); float* IW = (float*)(ws + 163 * MiB); float* IKRAW = (float*)(ws + 164 * MiB);
    float* OH = (float*)(ws + 168 * MiB);
    __half* OM = (__half*)(ws + 200 * MiB);
    float* Y = (float*)(ws + 33 * MiB);
    __half* ACT = (__half*)(ws + 97 * MiB);

    mod_kernel<<<6144 / 256, 256, 0, stream>>>(c, w_ada, b_ada, lbraw, MOD, LB);
    normmod_kernel<<<M_ / 4, 256, 0, stream>>>(x, n_pre_mix, MOD, 1024, 0, H);
    { EpiIn e{QH, LF, V, G, AQ, AK, AV, IQ, IKRAW, IW, LB}; gemm_naive<EpiIn, false><<<dim3((DIN + 63) / 64, M_ / 64), 256, 0, stream>>>(H, w_in, DIN, D_, DIN, 0, e); }
    fixup_kernel<<<M_ / 4, 256, 0, stream>>>(positions, AQ, AK, IQ, IKRAW, IK, knw, knb);
    hgrn_naive<<<16, 64, 0, stream>>>(QH, LF, V, OH);
    hgrn_post<<<M_, 256, 0, stream>>>(OH, G, onorm, OM);
    dsa_naive<<<M_, 256, 0, stream>>>(IQ, IK, IW, AQ, AK, AV, OM);
    { EpiF32 e{Y, D_}; gemm_naive<EpiF32, false><<<dim3(D_ / 64, M_ / 64), 256, 0, stream>>>(OM, w_out, D_, D_, D_, 0, e); }
    post_kernel<true><<<M_ / 4, 256, 0, stream>>>(x, Y, n_post_mix, MOD, 2048, out, n_pre_ffn, 4096, 3072, H);
    { EpiSwiGLU e{ACT}; gemm_naive<EpiSwiGLU, true><<<dim3(DFF / 64, M_ / 64), 256, 0, stream>>>(H, w_ffn_in, DFF, D_, 2 * DFF, DFF, e); }
    { EpiF32 e{Y, D_}; gemm_naive<EpiF32, false><<<dim3(D_ / 64, M_ / 64), 256, 0, stream>>>(ACT, w_ffn_out, D_, DFF, D_, 0, e); }
    post_kernel<false><<<M_ / 4, 256, 0, stream>>>(out, Y, n_post_ffn, MOD, 5120, out, nullptr, 0, 0, nullptr);
}
```

```cpp
#include <hip/hip_runtime.h>
#include <hip/hip_fp16.h>
#include <cstdio>
#include <cstdint>

namespace pg8 {
#define PG8_LAS __attribute__((address_space(3)))
typedef unsigned short h16_t;
typedef short bf16x8 __attribute__((ext_vector_type(8)));
typedef _Float16 half8 __attribute__((ext_vector_type(8)));
typedef float f32x4 __attribute__((ext_vector_type(4)));
typedef unsigned u32x4 __attribute__((ext_vector_type(4)));
constexpr int BM = 256, BK = 64, HALF = 128, HTB = HALF * BK * 2, STAGE_BYTES = 8 * HTB, NXCD = 8, WGM = 8;

__host__ __device__ __forceinline__ int lds_byte(int r, int c) { const int st = (r >> 4) * 2 + (c >> 5), rr = r & 15, cc = c & 31, ob = rr * 64 + cc * 2; return st * 1024 + (ob ^ (((ob >> 9) & 1) << 5)); }
__host__ __device__ __forceinline__ void stage_rc(int b, int& R, int& C) { const int st = b / 1024, sb = b % 1024, swz = sb ^ (((sb >> 9) & 1) << 5); R = (st >> 1) * 16 + swz / 64; C = (st & 1) * 32 + (swz % 64) / 2; }
__host__ __device__ __forceinline__ int perm32(int rho) { const int n = rho >> 4, i = rho & 15; return 8 * (i >> 2) + 4 * n + (i & 3); }

struct Unit { int pm, pn; };
struct Gemm { const h16_t* A; const h16_t* Bt; int M, N, K; };

struct StaticOrder {
    int nM, nN, nwg, G, c;
    __host__ __device__ void init(int M, int N, int G_, int c_) { nM = M / BM; nN = N / BM; nwg = nM * nN; G = G_; c = c_; }
    __host__ __device__ bool next(int i, Unit& u) const {
        const long L = (long)i * G + c; if (L >= nwg) return false;
        int wgid = (int)L; { const int q = nwg / NXCD, r = nwg % NXCD, xcd = wgid % NXCD, off = wgid / NXCD; wgid = (xcd < r ? xcd * (q + 1) : r * (q + 1) + (xcd - r) * q) + off; }
        const int nig = WGM * nN, gid = wgid / nig, fm = gid * WGM, gsz = (nM - fm) < WGM ? (nM - fm) : WGM;
        u.pm = fm + ((wgid % nig) % gsz); u.pn = (wgid % nig) / gsz; return true;
    }
    __device__ __forceinline__ void a_ready(const Unit&) const {}
    __device__ __forceinline__ void done(const Unit&) const {}
};

template <class Epi, class Sched, bool ALIGN_EPI = false, bool SP2 = false>
__device__ __forceinline__ void gemm_phase(PG8_LAS unsigned char* lds, const Gemm g, const Sched& S, const Epi& E) {
    const int tid = threadIdx.x, wid = __builtin_amdgcn_readfirstlane(tid >> 6), lane = tid & 63, wr = wid >> 2, wc = wid & 3, fr = lane & 15, fq = lane >> 4;
    const int K = g.K, nt = K / BK;
    unsigned voffA[2], voffB[2];
#pragma unroll
    for (int i = 0; i < 2; ++i) { int R, C; stage_rc(tid * 16 + i * 8192, R, C); const int Rb = Epi::PERM ? ((R & ~31) + perm32(R & 31)) : R;
        voffA[i] = (unsigned)(R * K + C) * 2u; voffB[i] = (unsigned)(Rb * K + C) * 2u; }
    const size_t kstep = (size_t)(BK * 2);
    const size_t hstep = (size_t)HALF * K * 2;
    const size_t tstep = 2 * hstep;
    const unsigned ldsw = (unsigned)wid * 1024u;
    const int aoff = lds_byte(wr * 64 + fr, fq * 8), boff = lds_byte(wc * 32 + fr, fq * 8);
#define PG8_SA(b, h) (((b) * 2 + (h)) * HTB)
#define PG8_SB(b, h) ((4 + (b) * 2 + (h)) * HTB)
#define PG8_STAGE(bufoff, gbase, voff) do { _Pragma("unroll") for (int _i = 0; _i < 2; ++_i) \
        __builtin_amdgcn_global_load_lds((const unsigned*)((const char*)(gbase) + (voff)[_i]), (PG8_LAS unsigned*)(lds + (bufoff) + ldsw + _i * 8192), 16, 0, 0); } while (0)
#define PG8_LDA(dst, b, h) do { _Pragma("unroll") for (int m = 0; m < 4; ++m) _Pragma("unroll") for (int k = 0; k < 2; ++k) dst[m][k] = *(const PG8_LAS bf16x8*)(lds + PG8_SA(b, h) + aoff + m * 2048 + k * 1024); } while (0)
#define PG8_LDB(dst, b, h) do { _Pragma("unroll") for (int n = 0; n < 2; ++n) _Pragma("unroll") for (int k = 0; k < 2; ++k) dst[n][k] = *(const PG8_LAS bf16x8*)(lds + PG8_SB(b, h) + boff + n * 2048 + k * 1024); } while (0)
#define PG8_MMA(ai, bj, At, Bt) do { __builtin_amdgcn_s_setprio(1); _Pragma("unroll") for (int m = 0; m < 4; ++m) _Pragma("unroll") for (int n = 0; n < 2; ++n) _Pragma("unroll") for (int k = 0; k < 2; ++k) \
        acc[ai][bj][m][n] = __builtin_amdgcn_mfma_f32_16x16x32_f16(__builtin_bit_cast(half8, Bt[n][k]), __builtin_bit_cast(half8, At[m][k]), acc[ai][bj][m][n], 0, 0, 0); __builtin_amdgcn_s_setprio(0); } while (0)
#define PG8_WAIT_V(n) asm volatile("s_waitcnt vmcnt(" #n ")" ::: "memory")
#define PG8_WAIT_L(n) asm volatile("s_waitcnt lgkmcnt(" #n ")" ::: "memory")
#define PG8_BAR __builtin_amdgcn_s_barrier()
#define PG8_SCHED __builtin_amdgcn_sched_barrier(0)
    Unit cur, nxt; int ui = 0;
    if (!S.next(0, cur)) return;
    f32x4 acc[2][2][4][2];
#pragma unroll
    for (int a = 0; a < 2; ++a)
#pragma unroll
        for (int b = 0; b < 2; ++b)
#pragma unroll
            for (int m = 0; m < 4; ++m)
#pragma unroll
                for (int n = 0; n < 2; ++n) acc[a][b][m][n] = (f32x4){0.f, 0.f, 0.f, 0.f};
    bf16x8 At[4][2], B0[2][2], B1[2][2];
    const char* cA = (const char*)g.A + (size_t)cur.pm * tstep; const char* cB = (const char*)g.Bt + (size_t)cur.pn * tstep;
    S.a_ready(cur);
    if constexpr (SP2) {
        PG8_STAGE(PG8_SB(0, 0), cB, voffB); PG8_STAGE(PG8_SB(0, 1), cB + hstep, voffB); PG8_STAGE(PG8_SA(0, 0), cA, voffA); PG8_STAGE(PG8_SA(0, 1), cA + hstep, voffA);
        if (wr == 1) PG8_BAR;
        PG8_WAIT_V(2); PG8_BAR;
        PG8_STAGE(PG8_SB(1, 0), cB + kstep, voffB); PG8_STAGE(PG8_SA(1, 0), cA + kstep, voffA); PG8_STAGE(PG8_SB(1, 1), cB + hstep + kstep, voffB);
        PG8_WAIT_V(6); PG8_BAR;
    } else {
        PG8_STAGE(PG8_SB(0, 0), cB, voffB); PG8_STAGE(PG8_SA(0, 0), cA, voffA); PG8_STAGE(PG8_SB(0, 1), cB + hstep, voffB); PG8_STAGE(PG8_SA(0, 1), cA + hstep, voffA);
        if (wr == 1) PG8_BAR;
        PG8_WAIT_V(4); PG8_BAR;
        PG8_STAGE(PG8_SB(1, 0), cB + kstep, voffB); PG8_STAGE(PG8_SA(1, 0), cA + kstep, voffA); PG8_STAGE(PG8_SB(1, 1), cB + hstep + kstep, voffB);
        PG8_WAIT_V(6); PG8_BAR;
    }
    for (;;) {
        const bool has_next = S.next(ui + 1, nxt);
        const char* nA = has_next ? (const char*)g.A + (size_t)nxt.pm * tstep : cA; const char* nB = has_next ? (const char*)g.Bt + (size_t)nxt.pn * tstep : cB;
        for (int t = 0; t < nt; t += 2) {
            const bool last = (t == nt - 2);
            const char* a1 = cA + (size_t)(t + 1) * kstep;
            const char* a2 = last ? nA : cA + (size_t)(t + 2) * kstep; const char* b2 = last ? nB : cB + (size_t)(t + 2) * kstep;
            const char* a3 = a2 + kstep; const char* b3 = b2 + kstep;
            if (last && has_next) S.a_ready(nxt);
            if constexpr (SP2) {
            PG8_LDB(B0, 0, 0); PG8_LDB(B1, 0, 1); PG8_SCHED; PG8_LDA(At, 0, 0); PG8_STAGE(PG8_SA(1, 1), a1 + hstep, voffA);
            PG8_WAIT_V(8); PG8_WAIT_L(0); PG8_BAR; PG8_MMA(0, 0, At, B0); PG8_MMA(0, 1, At, B1); PG8_BAR; PG8_SCHED;
            PG8_LDA(At, 0, 1); PG8_STAGE(PG8_SB(0, 0), b2, voffB); PG8_STAGE(PG8_SB(0, 1), b2 + hstep, voffB); PG8_STAGE(PG8_SA(0, 0), a2, voffA);
            PG8_WAIT_V(8); PG8_WAIT_L(0); PG8_BAR; PG8_MMA(1, 0, At, B0); PG8_MMA(1, 1, At, B1); PG8_BAR; PG8_SCHED;
            PG8_LDB(B0, 1, 0); PG8_LDB(B1, 1, 1); PG8_SCHED; PG8_LDA(At, 1, 0); PG8_STAGE(PG8_SA(0, 1), a2 + hstep, voffA);
            PG8_WAIT_V(8); PG8_WAIT_L(0); PG8_BAR; PG8_MMA(0, 0, At, B0); PG8_MMA(0, 1, At, B1); PG8_BAR; PG8_SCHED;
            PG8_LDA(At, 1, 1); PG8_STAGE(PG8_SB(1, 0), b3, voffB); PG8_STAGE(PG8_SB(1, 1), b3 + hstep, voffB); PG8_STAGE(PG8_SA(1, 0), a3, voffA);
            PG8_WAIT_V(8); PG8_WAIT_L(0); PG8_BAR; PG8_MMA(1, 0, At, B0); PG8_MMA(1, 1, At, B1); PG8_BAR; PG8_SCHED;
            } else {
            PG8_LDB(B0, 0, 0); PG8_SCHED; PG8_LDA(At, 0, 0); PG8_STAGE(PG8_SA(1, 1), a1 + hstep, voffA);
            PG8_WAIT_L(8); PG8_BAR; PG8_WAIT_L(0); PG8_MMA(0, 0, At, B0); PG8_BAR; PG8_SCHED;
            PG8_LDB(B1, 0, 1); PG8_STAGE(PG8_SB(0, 0), b2, voffB);
            PG8_BAR; PG8_WAIT_L(0); PG8_MMA(0, 1, At, B1); PG8_BAR;
            PG8_LDA(At, 0, 1); PG8_STAGE(PG8_SA(0, 0), a2, voffA);
            PG8_BAR; PG8_WAIT_L(0); PG8_MMA(1, 0, At, B0); PG8_BAR; PG8_SCHED;
            PG8_STAGE(PG8_SB(0, 1), b2 + hstep, voffB);
            PG8_WAIT_V(6); PG8_BAR; PG8_MMA(1, 1, At, B1); PG8_BAR;
            PG8_LDB(B0, 1, 0); PG8_SCHED; PG8_LDA(At, 1, 0); PG8_STAGE(PG8_SA(0, 1), a2 + hstep, voffA);
            PG8_WAIT_L(8); PG8_BAR; PG8_WAIT_L(0); PG8_MMA(0, 0, At, B0); PG8_BAR; PG8_SCHED;
            PG8_LDB(B1, 1, 1); PG8_STAGE(PG8_SB(1, 0), b3, voffB);
            PG8_BAR; PG8_WAIT_L(0); PG8_MMA(0, 1, At, B1); PG8_BAR;
            PG8_LDA(At, 1, 1); PG8_STAGE(PG8_SA(1, 0), a3, voffA);
            PG8_BAR; PG8_WAIT_L(0); PG8_MMA(1, 0, At, B0); PG8_BAR; PG8_SCHED;
            PG8_STAGE(PG8_SB(1, 1), b3 + hstep, voffB);
            PG8_WAIT_V(6); PG8_BAR; PG8_MMA(1, 1, At, B1); PG8_BAR;
            }
        }
        if constexpr (ALIGN_EPI) { if (wr == 0) PG8_BAR; }
        if constexpr (!Epi::AFTER_DRAIN) { E(acc, cur, wr, wc, fr, fq); S.done(cur); }
        if (!has_next) break;
#pragma unroll
        for (int a = 0; a < 2; ++a)
#pragma unroll
            for (int b = 0; b < 2; ++b)
#pragma unroll
                for (int m = 0; m < 4; ++m)
#pragma unroll
                    for (int n = 0; n < 2; ++n) acc[a][b][m][n] = (f32x4){0.f, 0.f, 0.f, 0.f};
        cur = nxt; cA = nA; cB = nB; ++ui;
        if constexpr (ALIGN_EPI) { if (wr == 1) PG8_BAR; }
    }
    PG8_WAIT_V(0);
    if constexpr (!ALIGN_EPI) { if (wr == 0) PG8_BAR; }
    PG8_BAR;
#undef PG8_SA
#undef PG8_SB
#undef PG8_STAGE
#undef PG8_LDA
#undef PG8_LDB
#undef PG8_MMA
#undef PG8_WAIT_V
#undef PG8_WAIT_L
#undef PG8_BAR
#undef PG8_SCHED
}
}

namespace {
constexpr int B_ = 2, T_ = 8192, D_ = 1024, M_ = B_ * T_;
constexpr int DIN = 4168, DIN_PAD = 4352, DFF = 2816;
constexpr float EPS = 1e-6f;
constexpr int NWAVES = 8, NTHR = 512;

#define GAS __attribute__((address_space(1)))
#define LAS __attribute__((address_space(3)))
typedef unsigned short h16;
typedef float f32x4 __attribute__((ext_vector_type(4)));
typedef unsigned u32x4 __attribute__((ext_vector_type(4)));
typedef unsigned u32x2 __attribute__((ext_vector_type(2)));

__constant__ float c_inv16[16] = {1.f, 0.440366596f, 0.193922743f, 0.0853971019f, 0.0376060307f, 0.0165604409f, 0.00729266461f, 0.00321144611f,
                                  0.00141421356f, 0.000622772437f, 0.000274248188f, 0.000120769735f, 5.31829573e-05f, 2.34199997e-05f, 1.03133852e-05f, 4.54167048e-06f};
__constant__ float c_inv8[8] = {1.f, 0.193922743f, 0.0376060307f, 0.00729266461f, 0.00141421356f, 0.000274248188f, 5.31829573e-05f, 1.03133852e-05f};

constexpr size_t MiB = 1u << 20;
constexpr size_t WS_CTL = 0, CTL_ZERO_BYTES = 1 * MiB;
constexpr size_t WS_MOD = 1 * MiB, WS_LB = 1 * MiB + 64 * 1024;
constexpr size_t WS_WIN = 2 * MiB, WS_WOUT = 11 * MiB, WS_WF1 = 13 * MiB, WS_WF2 = 24 * MiB;
constexpr size_t WS_XN = 30 * MiB;
constexpr size_t WS_GRP = 62 * MiB, GRP_STRIDE = 16 * MiB;
constexpr size_t WS_IK = 190 * MiB, WS_IW = 192 * MiB, WS_IKRAW = 193 * MiB;
constexpr size_t WS_OH = 197 * MiB;
constexpr size_t WS_Y = 62 * MiB;
constexpr size_t WS_ACT = 126 * MiB;
constexpr size_t WS_END = 229 * MiB;
constexpr int CW_BAR = 4096;

constexpr int RING_BYTES = 131072, LDSCTL_OFF = RING_BYTES, MISC_OFF = LDSCTL_OFF + 320, LDS_BYTES = 147456;

__device__ __forceinline__ float wave_sum(float v) {
#pragma unroll
    for (int o = 1; o < 64; o <<= 1) v += __shfl_xor(v, o);
    return v;
}
__device__ __forceinline__ float wave_max(float v) {
#pragma unroll
    for (int o = 1; o < 64; o <<= 1) v = fmaxf(v, __shfl_xor(v, o));
    return v;
}
__device__ __forceinline__ float sigmoidf_(float v) { return 1.f / (1.f + expf(-v)); }
__device__ __forceinline__ float siluf_(float v) { return v / (1.f + expf(-v)); }
__device__ __forceinline__ unsigned pk_f16(float lo, float hi) {
    typedef _Float16 h2 __attribute__((ext_vector_type(2))); typedef float f2 __attribute__((ext_vector_type(2)));
    const h2 h = __builtin_convertvector((f2){lo, hi}, h2); return __builtin_bit_cast(unsigned, h);
}
__device__ __forceinline__ float h2f(h16 v) { return (float)__builtin_bit_cast(_Float16, v); }
__device__ __forceinline__ h16 f2h(float v) { return __builtin_bit_cast(h16, (_Float16)v); }

__device__ __forceinline__ void sincos_acc(float ang, float& s, float& c) {
    const double a = (double)ang;
    const double n = rint(a * 0.63661977236758134308);
    double y = fma(-n, 1.57079632679489655800, a);
    y = fma(-n, 6.12323399573676603587e-17, y);
    const int q = (int)((long long)n & 3);
    const double y2 = y * y;
    const double sp = y * (1.0 + y2 * (-1.0 / 6.0 + y2 * (1.0 / 120.0 + y2 * (-1.0 / 5040.0 + y2 * (1.0 / 362880.0 + y2 * (-1.0 / 39916800.0 + y2 * (1.0 / 6227020800.0 + y2 * (-1.0 / 1307674368000.0))))))));
    const double cp = 1.0 + y2 * (-0.5 + y2 * (1.0 / 24.0 + y2 * (-1.0 / 720.0 + y2 * (1.0 / 40320.0 + y2 * (-1.0 / 3628800.0 + y2 * (1.0 / 479001600.0 + y2 * (-1.0 / 87178291200.0)))))));
    double sd, cd;
    if (q == 0) { sd = sp; cd = cp; } else if (q == 1) { sd = cp; cd = -sp; } else if (q == 2) { sd = -sp; cd = -cp; } else { sd = -cp; cd = sp; }
    s = (float)sd; c = (float)cd;
}

#define XB_TMO      128
#define XB_XCNT(j)  (256  + 64 * (j))
#define XB_XSUB(j)  (1280 + 64 * (j))
#define XB_XGEN(j)  (2304 + 64 * (j))
#define XB_TOP      3328
#define XB_TOPGEN   3392
#define XCD_BAR_WORDS 3456
#define XB_SPIN_CAP (1u << 22)
__device__ __forceinline__ unsigned xb_ld(unsigned* p)              { return __hip_atomic_load(p, __ATOMIC_RELAXED, __HIP_MEMORY_SCOPE_AGENT); }
__device__ __forceinline__ unsigned xb_add(unsigned* p, unsigned v) { return __hip_atomic_fetch_add(p, v, __ATOMIC_RELAXED, __HIP_MEMORY_SCOPE_AGENT); }
__device__ __forceinline__ unsigned xb_xcc_id() { return (unsigned)__builtin_amdgcn_s_getreg((3 << 11) | 20) & 0xFu; }
#define XB_SPIN(cond, bar) do { unsigned _sp = 0; while (cond) { __builtin_amdgcn_s_sleep(1); \
    if ((++_sp & 255u) == 0u) { if (xb_ld(&(bar)[XB_TMO])) break; if (_sp > XB_SPIN_CAP) { atomicAdd(&(bar)[XB_TMO], 1u); break; } } } } while (0)
struct XcdBarrier { unsigned* bar; unsigned x; volatile LAS unsigned* st; };
__device__ __forceinline__ XcdBarrier xcd_barrier_post(unsigned* bar, volatile LAS unsigned* st) {
    XcdBarrier b; b.bar = bar; b.x = xb_xcc_id(); b.st = st;
    if (threadIdx.x == 0) (void)xb_add(&bar[XB_XCNT(b.x)], 1u);
    return b;
}
__device__ __forceinline__ void xcd_barrier_complete(unsigned* bar, unsigned x, unsigned& nloc, unsigned& nx) {
    const unsigned G = gridDim.x * gridDim.y * gridDim.z;
    unsigned sum, cnt, mine, sp = 0u;
    for (;;) {
        sum = 0u; cnt = 0u; mine = 0u;
#pragma unroll
        for (unsigned j = 0; j < 16; ++j) { const unsigned c = xb_ld(&bar[XB_XCNT(j)]); sum += c; cnt += (c > 0u) ? 1u : 0u; mine = (j == x) ? c : mine; }
        if (sum == G) break;
        __builtin_amdgcn_s_sleep(1);
        if ((++sp & 255u) == 0u) { if (xb_ld(&bar[XB_TMO])) break; if (sp > XB_SPIN_CAP) { atomicAdd(&bar[XB_TMO], 1u); break; } }
    }
    nloc = mine > 0u ? mine : 1u; nx = cnt > 0u ? cnt : 1u;
}
__device__ __forceinline__ void xcd_barrier(const XcdBarrier& b) {
    asm volatile("s_waitcnt vmcnt(0)" ::: "memory");
    __syncthreads();
    if (threadIdx.x == 0) {
        unsigned* bar = b.bar;
        __builtin_amdgcn_s_waitcnt(0);
        unsigned nloc = b.st[0], nx = b.st[1];
        if (nloc == 0u) { xcd_barrier_complete(bar, b.x, nloc, nx); b.st[0] = nloc; b.st[1] = nx; }
        const unsigned old = xb_add(&bar[XB_XSUB(b.x)], 1u);
        const unsigned gen = old / nloc;
        if (old + 1u == (gen + 1u) * nloc) {
            __builtin_amdgcn_fence(__ATOMIC_RELEASE, "agent");
            asm volatile("s_waitcnt vmcnt(0)" ::: "memory");
            const unsigned og = xb_add(&bar[XB_TOP], 1u);
            const unsigned tg = og / nx;
            if (og + 1u == (tg + 1u) * nx) xb_add(&bar[XB_TOPGEN], 1u);
            else XB_SPIN(xb_ld(&bar[XB_TOPGEN]) == tg, bar);
            __builtin_amdgcn_fence(__ATOMIC_ACQUIRE, "agent");
            xb_add(&bar[XB_XGEN(b.x)], 1u);
            asm volatile("s_waitcnt vmcnt(0)" ::: "memory");
        } else {
            XB_SPIN(xb_ld(&bar[XB_XGEN(b.x)]) == gen, bar);
            __builtin_amdgcn_fence(__ATOMIC_ACQUIRE, "agent");
            asm volatile("s_waitcnt vmcnt(0)" ::: "memory");
        }
    }
    __syncthreads();
}

struct EpiIn16 {
    static constexpr bool PERM = true, AFTER_DRAIN = false;
    h16* grp; float* IKRAW; float* IW; const float* lb;
    __device__ __forceinline__ void operator()(const f32x4 (&acc)[2][2][4][2], const pg8::Unit& u, int wr, int wc, int fr, int fq) const {
        const int row0 = u.pm * 256 + wr * 64 + fr;
        if (u.pn < 16) {
            const int g = u.pn >> 1;
            const int jc0 = (u.pn & 1) * 256 + wc * 32 + 8 * fq;
            h16* gb = grp + (size_t)g * ((size_t)M_ * 512);
            float lbv[2][8];
            if (g == 1) {
#pragma unroll
                for (int bj = 0; bj < 2; ++bj)
#pragma unroll
                    for (int e = 0; e < 8; ++e) lbv[bj][e] = lb[jc0 + bj * 128 + e];
            }
#pragma unroll
            for (int ai = 0; ai < 2; ++ai)
#pragma unroll
                for (int m = 0; m < 4; ++m) {
                    h16* rowp = gb + (size_t)(row0 + ai * 128 + m * 16) * 512 + jc0;
#pragma unroll
                    for (int bj = 0; bj < 2; ++bj) {
                        float v[8];
#pragma unroll
                        for (int e = 0; e < 4; ++e) { v[e] = acc[ai][bj][m][0][e]; v[4 + e] = acc[ai][bj][m][1][e]; }
                        if (g == 0) {
#pragma unroll
                            for (int e = 0; e < 8; ++e) v[e] = siluf_(v[e]) * 0.08838834764831845f;
                        } else if (g == 1) {
#pragma unroll
                            for (int e = 0; e < 8; ++e) { const float l = lbv[bj][e]; v[e] = logf(l + (1.f - l) * sigmoidf_(v[e])); }
                        } else if (g == 3) {
#pragma unroll
                            for (int e = 0; e < 8; ++e) v[e] = siluf_(v[e]);
                        } else if (g == 4) {
#pragma unroll
                            for (int e = 0; e < 8; ++e) v[e] *= 0.08838834764831845f;
                        }
                        u32x4 w; w.x = pk_f16(v[0], v[1]); w.y = pk_f16(v[2], v[3]); w.z = pk_f16(v[4], v[5]); w.w = pk_f16(v[6], v[7]);
                        *(u32x4*)(rowp + bj * 128) = w;
                    }
                }
        } else {
#pragma unroll
            for (int ai = 0; ai < 2; ++ai)
#pragma unroll
                for (int m = 0; m < 4; ++m) {
                    const int row = row0 + ai * 128 + m * 16;
                    const f32x4 v0 = acc[ai][0][m][0], v1 = acc[ai][0][m][1];
                    if (wc < 2) { float* p = IKRAW + (size_t)row * 64 + wc * 32 + 8 * fq; *(f32x4*)p = v0; *(f32x4*)(p + 4) = v1; }
                    else if (wc == 2 && fq == 0) { float* p = IW + (size_t)row * 8; *(f32x4*)p = v0 * 0.04419417382415922f; *(f32x4*)(p + 4) = v1 * 0.04419417382415922f; }
                }
        }
    }
};
struct EpiStoreF32 {
    static constexpr bool PERM = false, AFTER_DRAIN = false;
    float* Y; int ldc;
    __device__ __forceinline__ void operator()(const f32x4 (&acc)[2][2][4][2], const pg8::Unit& u, int wr, int wc, int fr, int fq) const {
        const int row0 = u.pm * 256 + wr * 64 + fr, col0 = u.pn * 256 + wc * 32 + 4 * fq;
#pragma unroll
        for (int ai = 0; ai < 2; ++ai)
#pragma unroll
            for (int m = 0; m < 4; ++m) {
                float* rowp = Y + (size_t)(row0 + ai * 128 + m * 16) * ldc + col0;
#pragma unroll
                for (int bj = 0; bj < 2; ++bj)
#pragma unroll
                    for (int n = 0; n < 2; ++n) *(f32x4*)(rowp + bj * 128 + n * 16) = acc[ai][bj][m][n];
            }
    }
};
struct EpiSwiGLU16 {
    static constexpr bool PERM = true, AFTER_DRAIN = false;
    h16* ACT;
    __device__ __forceinline__ void operator()(const f32x4 (&acc)[2][2][4][2], const pg8::Unit& u, int wr, int wc, int fr, int fq) const {
        const int row0 = u.pm * 256 + wr * 64 + fr, hc0 = u.pn * 128 + wc * 32 + 8 * fq;
#pragma unroll
        for (int ai = 0; ai < 2; ++ai)
#pragma unroll
            for (int m = 0; m < 4; ++m) {
                float v[8];
#pragma unroll
                for (int e = 0; e < 4; ++e) { v[e] = siluf_(acc[ai][0][m][0][e]) * acc[ai][1][m][0][e]; v[4 + e] = siluf_(acc[ai][0][m][1][e]) * acc[ai][1][m][1][e]; }
                u32x4 w; w.x = pk_f16(v[0], v[1]); w.y = pk_f16(v[2], v[3]); w.z = pk_f16(v[4], v[5]); w.w = pk_f16(v[6], v[7]);
                *(u32x4*)(ACT + (size_t)(row0 + ai * 128 + m * 16) * DFF + hc0) = w;
            }
    }
};

__device__ __forceinline__ void transpose_item(const float* __restrict__ W, int ldw, int src_col0, int valid, h16* __restrict__ WT, int K, int dst_row0, int k0, LAS float* scr, int lane) {
    const bool ok = (lane & 31) < valid;
#pragma unroll 8
    for (int i = 0; i < 32; ++i) { const int kk = 2 * i + (lane >> 5); scr[kk * 33 + (lane & 31)] = ok ? W[(size_t)(k0 + kk) * ldw + src_col0 + (lane & 31)] : 0.f; }
    asm volatile("s_waitcnt lgkmcnt(0)" ::: "memory");
    const int c = lane & 7;
#pragma unroll
    for (int j = 0; j < 4; ++j) { const int n = (lane >> 3) + 8 * j; const LAS float* s = scr + (8 * c) * 33 + n;
        u32x4 o; o.x = pk_f16(s[0 * 33], s[1 * 33]); o.y = pk_f16(s[2 * 33], s[3 * 33]); o.z = pk_f16(s[4 * 33], s[5 * 33]); o.w = pk_f16(s[6 * 33], s[7 * 33]);
        *(u32x4*)(WT + (size_t)(dst_row0 + n) * K + k0 + 8 * c) = o; }
    asm volatile("s_waitcnt lgkmcnt(0)" ::: "memory");
}

struct Args {
    const float* x; const float* c; const int* positions; const float* w_ada; const float* b_ada;
    const float* n_pre_mix; const float* n_post_mix; const float* n_pre_ffn; const float* n_post_ffn;
    const float* w_in; const float* lbraw; const float* onorm; const float* knw; const float* knb;
    const float* w_out; const float* w_ffn_in; const float* w_ffn_out;
    float* out; unsigned char* ws;
};

__device__ __forceinline__ void normmod_row(const float* __restrict__ xrow, const float* __restrict__ gain, const float* __restrict__ mb, int sc_off, int sh_off, h16* __restrict__ hrow, int lane) {
    const f32x4* xr = (const f32x4*)xrow;
    f32x4 v[4]; float ss = 0.f;
#pragma unroll
    for (int j = 0; j < 4; ++j) { v[j] = xr[lane + 64 * j]; ss += v[j].x * v[j].x + v[j].y * v[j].y + v[j].z * v[j].z + v[j].w * v[j].w; }
    const float r = rsqrtf(wave_sum(ss) * (1.f / D_) + EPS);
#pragma unroll
    for (int j = 0; j < 4; ++j) {
        const int col = (lane + 64 * j) * 4;
        const f32x4 g4 = *(const f32x4*)(gain + col), s4 = *(const f32x4*)(mb + sc_off + col), h4 = *(const f32x4*)(mb + sh_off + col);
        u32x2 w; w.x = pk_f16(v[j].x * r * g4.x * (1.f + s4.x) + h4.x, v[j].y * r * g4.y * (1.f + s4.y) + h4.y);
        w.y = pk_f16(v[j].z * r * g4.z * (1.f + s4.z) + h4.z, v[j].w * r * g4.w * (1.f + s4.w) + h4.w);
        *(u32x2*)(hrow + col) = w;
    }
}

template <bool NEXT>
__device__ __forceinline__ void post_row(const float* xin, const float* __restrict__ Yrow, const float* __restrict__ g_post, const float* __restrict__ mb, int gt_off,
                                         float* xout, const float* __restrict__ g_pre, int sc_off, int sh_off, h16* __restrict__ hrow, int lane) {
    const f32x4* yr = (const f32x4*)Yrow; const f32x4* xr = (const f32x4*)xin; f32x4* xo = (f32x4*)xout;
    f32x4 y[4], xv[4]; float ss = 0.f;
#pragma unroll
    for (int j = 0; j < 4; ++j) { y[j] = yr[lane + 64 * j]; xv[j] = xr[lane + 64 * j]; ss += y[j].x * y[j].x + y[j].y * y[j].y + y[j].z * y[j].z + y[j].w * y[j].w; }
    const float r = rsqrtf(wave_sum(ss) * (1.f / D_) + EPS);
    float s2 = 0.f;
#pragma unroll
    for (int j = 0; j < 4; ++j) {
        const int col = (lane + 64 * j) * 4;
        const f32x4 g4 = *(const f32x4*)(g_post + col), t4 = *(const f32x4*)(mb + gt_off + col);
        xv[j].x += t4.x * (y[j].x * r * g4.x); xv[j].y += t4.y * (y[j].y * r * g4.y); xv[j].z += t4.z * (y[j].z * r * g4.z); xv[j].w += t4.w * (y[j].w * r * g4.w);
        xo[lane + 64 * j] = xv[j];
        s2 += xv[j].x * xv[j].x + xv[j].y * xv[j].y + xv[j].z * xv[j].z + xv[j].w * xv[j].w;
    }
    if (NEXT) {
        const float r2 = rsqrtf(wave_sum(s2) * (1.f / D_) + EPS);
#pragma unroll
        for (int j = 0; j < 4; ++j) {
            const int col = (lane + 64 * j) * 4;
            const f32x4 g4 = *(const f32x4*)(g_pre + col), s4 = *(const f32x4*)(mb + sc_off + col), h4 = *(const f32x4*)(mb + sh_off + col);
            u32x2 w; w.x = pk_f16(xv[j].x * r2 * g4.x * (1.f + s4.x) + h4.x, xv[j].y * r2 * g4.y * (1.f + s4.y) + h4.y);
            w.y = pk_f16(xv[j].z * r2 * g4.z * (1.f + s4.z) + h4.z, xv[j].w * r2 * g4.w * (1.f + s4.w) + h4.w);
            *(u32x2*)(hrow + col) = w;
        }
    }
}

__device__ __forceinline__ void fixup_row(int m, const int* __restrict__ positions, h16* AQ, h16* AK, h16* IQ, const float* __restrict__ IKRAW, h16* __restrict__ IK,
                                          const float* __restrict__ knw, const float* __restrict__ knb, int lane) {
    const float pos = (float)positions[m];
    float s_, c_;
    { const float inv = lane < 16 ? c_inv16[lane] : c_inv8[lane & 7]; sincos_acc(pos * inv, s_, c_); }
    {
        const int h = lane >> 4, i = lane & 15;
        const float cs = __shfl(c_, i), sn = __shfl(s_, i);
        const size_t o = (size_t)m * 512 + h * 128 + i;
        { const float x1 = h2f(AQ[o]), x2 = h2f(AQ[o + 16]); AQ[o] = f2h(x1 * cs - x2 * sn); AQ[o + 16] = f2h(x2 * cs + x1 * sn); }
        { const float x1 = h2f(AK[o]), x2 = h2f(AK[o + 16]); AK[o] = f2h(x1 * cs - x2 * sn); AK[o + 16] = f2h(x2 * cs + x1 * sn); }
    }
    {
        const int h = lane >> 3, i = lane & 7;
        const float cs = __shfl(c_, 16 + i), sn = __shfl(s_, 16 + i);
        const size_t o = (size_t)m * 512 + h * 64 + i;
        const float x1 = h2f(IQ[o]), x2 = h2f(IQ[o + 8]); IQ[o] = f2h(x1 * cs - x2 * sn); IQ[o + 8] = f2h(x2 * cs + x1 * sn);
    }
    {
        const float v = IKRAW[(size_t)m * 64 + lane];
        const float mu = wave_sum(v) * (1.f / 64.f);
        const float d = v - mu;
        const float var = wave_sum(d * d) * (1.f / 64.f);
        float y = d * rsqrtf(var + EPS) * knw[lane] + knb[lane];
        const float other = __shfl_xor(y, 8);
        const float cs = __shfl(c_, 16 + (lane & 7)), sn = __shfl(s_, 16 + (lane & 7));
        if (lane < 8) y = y * cs - other * sn; else if (lane < 16) y = y * cs + other * sn;
        IK[(size_t)m * 64 + lane] = f2h(y);
    }
}

__device__ __forceinline__ void hgrn_naive_task(int task, const h16* __restrict__ QH, const h16* __restrict__ LF, const h16* __restrict__ V, float* __restrict__ OH, int lane) {
    const int bh = task >> 1, b = bh >> 2, h = bh & 3, j = (task & 1) * 64 + lane;
    float S[128];
#pragma unroll
    for (int k = 0; k < 128; ++k) S[k] = 0.f;
    for (int t = 0; t < T_; ++t) {
        const size_t row = (size_t)(b * T_ + t) * 512 + h * 128;
        const float v = h2f(V[row + j]);
        const float f0 = expf(h2f(LF[row + lane])), f1 = expf(h2f(LF[row + 64 + lane]));
        const float q0 = h2f(QH[row + lane]), q1 = h2f(QH[row + 64 + lane]);
        float o = 0.f;
#pragma unroll
        for (int k = 0; k < 64; ++k) {
            const float f = __int_as_float(__builtin_amdgcn_readlane(__float_as_int(f0), k)), q = __int_as_float(__builtin_amdgcn_readlane(__float_as_int(q0), k));
            S[k] = fmaf(f, S[k] - v, v); o = fmaf(q, S[k], o);
        }
#pragma unroll
        for (int k = 0; k < 64; ++k) {
            const float f = __int_as_float(__builtin_amdgcn_readlane(__float_as_int(f1), k)), q = __int_as_float(__builtin_amdgcn_readlane(__float_as_int(q1), k));
            S[64 + k] = fmaf(f, S[64 + k] - v, v); o = fmaf(q, S[64 + k], o);
        }
        OH[row + j] = o;
    }
}

__device__ __forceinline__ unsigned tokey(float f) { const unsigned u = __float_as_uint(f); return (u & 0x80000000u) ? ~u : (u | 0x80000000u); }
#define SCI(s) ((s) + ((s) >> 5))
__device__ __forceinline__ void dsa_query(int m, LAS unsigned char* lds, const h16* __restrict__ IQ, const h16* __restrict__ IK, const float* __restrict__ IW,
                                          const h16* __restrict__ AQ, const h16* __restrict__ AK, const h16* __restrict__ AV, h16* __restrict__ OM) {
    LAS float* sc = (LAS float*)lds;
    LAS float* qi = (LAS float*)(lds + 33792);
    LAS float* qa = (LAS float*)(lds + 35840);
    LAS float* wv = (LAS float*)(lds + 37888);
    LAS unsigned* hist = (LAS unsigned*)(lds + 37920);
    LAS int* sel = (LAS int*)(lds + 38944);
    LAS int* cnt_gt = (LAS int*)(lds + 39968);
    LAS int* cnt_eq = (LAS int*)(lds + 42016);
    LAS float* lg = (LAS float*)(lds + 44064);
    LAS unsigned* shp = (LAS unsigned*)(lds + 48160);
    const int b = m / T_, t = m % T_, n = t + 1, tid = threadIdx.x;
    __syncthreads();
    { qi[tid] = h2f(IQ[(size_t)m * 512 + tid]); qa[tid] = h2f(AQ[(size_t)m * 512 + tid]); }
    if (tid < 8) wv[tid] = IW[(size_t)m * 8 + tid];
    __syncthreads();
    for (int s = tid; s < n; s += NTHR) {
        const u32x4* kr = (const u32x4*)(IK + (size_t)(b * T_ + s) * 64);
        float kf[64];
#pragma unroll
        for (int i = 0; i < 8; ++i) {
            const u32x4 u = kr[i];
            const unsigned w[4] = {u.x, u.y, u.z, u.w};
#pragma unroll
            for (int e = 0; e < 4; ++e) { kf[i * 8 + e * 2] = h2f((h16)(w[e] & 0xffff)); kf[i * 8 + e * 2 + 1] = h2f((h16)(w[e] >> 16)); }
        }
        float score = 0.f;
#pragma unroll
        for (int h = 0; h < 8; ++h) {
            float d = 0.f;
#pragma unroll
            for (int e = 0; e < 64; ++e) d = fmaf(qi[h * 64 + e], kf[e], d);
            score = fmaf(wv[h], fmaxf(d, 0.f), score);
        }
        if (score == 0.f) score = 0.f;
        sc[SCI(s)] = score;
    }
    __syncthreads();
    int nsel;
    if (n <= 256) {
        if (tid < n) sel[tid] = tid;
        nsel = n;
    } else {
        unsigned prefix = 0; int remaining = 256;
        for (int pass = 0; pass < 4; ++pass) {
            const int shift = 24 - 8 * pass;
            if (tid < 256) hist[tid] = 0u;
            __syncthreads();
            for (int i = 0; i < 16; ++i) {
                const int s = tid * 16 + i;
                if (s < n) {
                    const unsigned key = tokey(sc[SCI(s)]);
                    if (pass == 0 || (unsigned)((unsigned long long)key >> (shift + 8)) == prefix) __hip_atomic_fetch_add((unsigned*)(hist + ((key >> shift) & 255u)), 1u, __ATOMIC_RELAXED, __HIP_MEMORY_SCOPE_WORKGROUP);
                }
            }
            __syncthreads();
            if (tid == 0) {
                int cum = 0, bin = 255;
                for (; bin > 0; --bin) { const int c = (int)hist[bin]; if (cum + c >= remaining) break; cum += c; }
                shp[0] = (prefix << 8) | (unsigned)bin; shp[1] = (unsigned)(remaining - cum);
            }
            __syncthreads();
            prefix = shp[0]; remaining = (int)shp[1];
        }
        const unsigned thr = prefix;
        int cg = 0, ce = 0;
        for (int i = 0; i < 16; ++i) { const int s = tid * 16 + i; if (s < n) { const unsigned key = tokey(sc[SCI(s)]); cg += key > thr; ce += key == thr; } }
        cnt_gt[tid] = cg; cnt_eq[tid] = ce;
        __syncthreads();
        if (tid == 0) { int a = 0, e = 0; for (int i = 0; i < NTHR; ++i) { const int g0 = cnt_gt[i], e0 = cnt_eq[i]; cnt_gt[i] = a; cnt_eq[i] = e; a += g0; e += e0; } }
        __syncthreads();
        int pg = cnt_gt[tid], pe = cnt_eq[tid];
        const int ngt = 256 - remaining;
        for (int i = 0; i < 16; ++i) {
            const int s = tid * 16 + i;
            if (s < n) {
                const unsigned key = tokey(sc[SCI(s)]);
                if (key > thr) { if (pg < 256) sel[pg] = s; ++pg; }
                else if (key == thr) { if (pe < remaining) sel[ngt + pe] = s; ++pe; }
            }
        }
        nsel = 256;
    }
    __syncthreads();
    {
        const int j = tid & 255, hp = tid >> 8;
        if (j < nsel) {
            const u32x4* kr = (const u32x4*)(AK + (size_t)(b * T_ + sel[j]) * 512);
#pragma unroll 1
            for (int hh = 0; hh < 2; ++hh) {
                const int h = hp * 2 + hh;
                float d = 0.f;
#pragma unroll 4
                for (int i = 0; i < 16; ++i) {
                    const u32x4 u = kr[h * 16 + i];
                    const unsigned w[4] = {u.x, u.y, u.z, u.w};
#pragma unroll
                    for (int e = 0; e < 4; ++e) {
                        d = fmaf(qa[h * 128 + i * 8 + e * 2], h2f((h16)(w[e] & 0xffff)), d);
                        d = fmaf(qa[h * 128 + i * 8 + e * 2 + 1], h2f((h16)(w[e] >> 16)), d);
                    }
                }
                lg[h * 256 + j] = d;
            }
        } else { lg[(hp * 2) * 256 + j] = -INFINITY; lg[(hp * 2 + 1) * 256 + j] = -INFINITY; }
    }
    __syncthreads();
    {
        const int w = tid >> 6, lane = tid & 63;
        if (w < 4) {
            float l[4]; float mx = -INFINITY;
#pragma unroll
            for (int i = 0; i < 4; ++i) { l[i] = lg[w * 256 + lane + 64 * i]; mx = fmaxf(mx, l[i]); }
            mx = wave_max(mx);
            float sum = 0.f;
#pragma unroll
            for (int i = 0; i < 4; ++i) { l[i] = (lane + 64 * i < nsel) ? expf(l[i] - mx) : 0.f; sum += l[i]; }
            sum = wave_sum(sum);
            const float inv = 1.f / sum;
#pragma unroll
            for (int i = 0; i < 4; ++i) lg[w * 256 + lane + 64 * i] = l[i] * inv;
        }
    }
    __syncthreads();
    {
        const int c0 = tid, h0 = c0 >> 7;
        float o0 = 0.f;
        for (int j = 0; j < nsel; ++j) o0 = fmaf(lg[h0 * 256 + j], h2f(AV[(size_t)(b * T_ + sel[j]) * 512 + c0]), o0);
        OM[(size_t)m * 1024 + 512 + c0] = f2h(o0);
    }
}

__global__ void __launch_bounds__(NTHR, 2) fwd_kernel(Args a) {
    extern __shared__ __attribute__((aligned(16))) unsigned char lds_raw[];
    LAS unsigned char* lds = (LAS unsigned char*)lds_raw;
    volatile LAS unsigned* MISC = (volatile LAS unsigned*)(lds + MISC_OFF);
    const int tid = threadIdx.x, lane = tid & 63, wave = __builtin_amdgcn_readfirstlane(tid >> 6);
    const int G = gridDim.x, bx = blockIdx.x;
    unsigned char* ws = a.ws;
    unsigned* ctl = (unsigned*)(ws + WS_CTL);
    for (int u = tid; u < (LDS_BYTES - LDSCTL_OFF) / 4; u += NTHR) ((LAS unsigned*)(lds + LDSCTL_OFF))[u] = 0u;
    __syncthreads();
    XcdBarrier bar = xcd_barrier_post(ctl + CW_BAR, MISC + 8);
#define GRID_BAR() xcd_barrier(bar)

    float* MOD = (float*)(ws + WS_MOD); float* LB = (float*)(ws + WS_LB);
    h16* WIN = (h16*)(ws + WS_WIN); h16* WOUT = (h16*)(ws + WS_WOUT); h16* WF1 = (h16*)(ws + WS_WF1); h16* WF2 = (h16*)(ws + WS_WF2);
    h16* XN = (h16*)(ws + WS_XN); h16* OM = XN;
    h16* GRP = (h16*)(ws + WS_GRP);
    h16* QH = GRP; h16* LF = (h16*)(ws + WS_GRP + GRP_STRIDE); h16* V = (h16*)(ws + WS_GRP + 2 * GRP_STRIDE); h16* Gt = (h16*)(ws + WS_GRP + 3 * GRP_STRIDE);
    h16* AQ = (h16*)(ws + WS_GRP + 4 * GRP_STRIDE); h16* AK = (h16*)(ws + WS_GRP + 5 * GRP_STRIDE); h16* AV = (h16*)(ws + WS_GRP + 6 * GRP_STRIDE); h16* IQ = (h16*)(ws + WS_GRP + 7 * GRP_STRIDE);
    h16* IK = (h16*)(ws + WS_IK); float* IW = (float*)(ws + WS_IW); float* IKRAW = (float*)(ws + WS_IKRAW);
    float* OH = (float*)(ws + WS_OH); float* Y = (float*)(ws + WS_Y); h16* ACT = (h16*)(ws + WS_ACT);
    const int gw = bx * NWAVES + wave, NGW = G * NWAVES;

    {
        LAS float* scr = (LAS float*)(lds + wave * 16384);
        constexpr int I_IN = (DIN_PAD / 32) * (D_ / 64), I_OUT = (D_ / 32) * (D_ / 64), I_F1 = (2 * DFF / 32) * (D_ / 64), I_F2 = (D_ / 32) * (DFF / 64);
        for (int it = gw; it < I_IN + I_OUT + I_F1 + I_F2; it += NGW) {
            int r = it;
            if (r < I_IN) { const int rb = r / (D_ / 64), kb = r % (D_ / 64); const int valid = DIN - rb * 32; transpose_item(a.w_in, DIN, rb * 32, valid < 0 ? 0 : valid, WIN, D_, rb * 32, kb * 64, scr, lane); continue; } r -= I_IN;
            if (r < I_OUT) { const int rb = r / (D_ / 64), kb = r % (D_ / 64); transpose_item(a.w_out, D_, rb * 32, 32, WOUT, D_, rb * 32, kb * 64, scr, lane); continue; } r -= I_OUT;
            if (r < I_F1) { const int rb = r / (D_ / 64), kb = r % (D_ / 64); const int drow = rb * 32, pn = drow >> 8, bj = (drow >> 7) & 1, i0 = drow & 127;
                transpose_item(a.w_ffn_in, 2 * DFF, bj * DFF + pn * 128 + i0, 32, WF1, D_, drow, kb * 64, scr, lane); continue; } r -= I_F1;
            { const int rb = r / (DFF / 64), kb = r % (DFF / 64); transpose_item(a.w_ffn_out, D_, rb * 32, 32, WF2, DFF, rb * 32, kb * 64, scr, lane); }
        }
        __syncthreads();
        LAS float* scs = (LAS float*)lds;
        LAS float* part = (LAS float*)(lds + 8192);
        for (int i = tid; i < 2048; i += NTHR) scs[i] = siluf_(a.c[i]);
        __syncthreads();
        for (int cb = bx; cb < 256; cb += G) {
            const int rl = tid / 6, q = tid % 6;
            if (rl < 85) {
                f32x4 a0 = {0.f, 0.f, 0.f, 0.f}, a1 = {0.f, 0.f, 0.f, 0.f};
                for (int d = rl; d < 1024; d += 85) { const f32x4 w4 = *(const f32x4*)(a.w_ada + (size_t)d * 6144 + 24 * cb + 4 * q); a0 += w4 * scs[d]; a1 += w4 * scs[1024 + d]; }
#pragma unroll
                for (int e = 0; e < 4; ++e) { part[(rl * 2 + 0) * 24 + 4 * q + e] = a0[e]; part[(rl * 2 + 1) * 24 + 4 * q + e] = a1[e]; }
            }
            __syncthreads();
            if (tid < 48) { const int bb = tid / 24, col = tid % 24; float s = 0.f; for (int r2 = 0; r2 < 85; ++r2) s += part[(r2 * 2 + bb) * 24 + col]; MOD[bb * 6144 + 24 * cb + col] = s + a.b_ada[24 * cb + col]; }
            __syncthreads();
        }
        if (bx == 0) for (int i = tid; i < 512; i += NTHR) LB[i] = 1.f / (1.f + expf(a.lbraw[512 + i] - a.lbraw[i]));
    }
    GRID_BAR();
    for (int m = gw; m < M_; m += NGW) normmod_row(a.x + (size_t)m * D_, a.n_pre_mix, MOD + (m / T_) * 6144, 1024, 0, XN + (size_t)m * D_, lane);
    GRID_BAR();
    {
        pg8::Gemm g{XN, WIN, M_, DIN_PAD, D_}; pg8::StaticOrder S; S.init(M_, DIN_PAD, G, bx);
        EpiIn16 E{GRP, IKRAW, IW, LB};
        pg8::gemm_phase<EpiIn16, pg8::StaticOrder, true, true>(lds, g, S, E);
    }
    GRID_BAR();
    for (int m = gw; m < M_; m += NGW) fixup_row(m, a.positions, AQ, AK, IQ, IKRAW, IK, a.knw, a.knb, lane);
    GRID_BAR();
    if (bx < 16) { if (wave == 0) hgrn_naive_task(bx, QH, LF, V, OH, lane); }
    else { for (int i = bx - 16; i < M_; i += G - 16) dsa_query((M_ - 1) - i, lds, IQ, IK, IW, AQ, AK, AV, OM); }
    GRID_BAR();
    for (int idx = gw; idx < M_ * 4; idx += NGW) {
        const int m = idx >> 2, h = idx & 3; const size_t o = (size_t)m * 512 + h * 128;
        const float v0 = OH[o + lane], v1 = OH[o + 64 + lane];
        const float r = rsqrtf(wave_sum(v0 * v0 + v1 * v1) * (1.f / 128.f) + EPS);
        OM[(size_t)m * 1024 + h * 128 + lane] = f2h(v0 * r * a.onorm[h * 128 + lane] * h2f(Gt[o + lane]));
        OM[(size_t)m * 1024 + h * 128 + 64 + lane] = f2h(v1 * r * a.onorm[h * 128 + 64 + lane] * h2f(Gt[o + 64 + lane]));
    }
    GRID_BAR();
    {
        pg8::Gemm g{OM, WOUT, M_, D_, D_}; pg8::StaticOrder S; S.init(M_, D_, G, bx);
        EpiStoreF32 E{Y, D_};
        pg8::gemm_phase<EpiStoreF32, pg8::StaticOrder, true, true>(lds, g, S, E);
    }
    GRID_BAR();
    for (int m = gw; m < M_; m += NGW)
        post_row<true>(a.x + (size_t)m * D_, Y + (size_t)m * D_, a.n_post_mix, MOD + (m / T_) * 6144, 2048, a.out + (size_t)m * D_, a.n_pre_ffn, 4096, 3072, XN + (size_t)m * D_, lane);
    GRID_BAR();
    {
        pg8::Gemm g{XN, WF1, M_, 2 * DFF, D_}; pg8::StaticOrder S; S.init(M_, 2 * DFF, G, bx);
        EpiSwiGLU16 E{ACT};
        pg8::gemm_phase<EpiSwiGLU16, pg8::StaticOrder, true, true>(lds, g, S, E);
    }
    GRID_BAR();
    {
        pg8::Gemm g{ACT, WF2, M_, D_, DFF}; pg8::StaticOrder S; S.init(M_, D_, G, bx);
        EpiStoreF32 E{Y, D_};
        pg8::gemm_phase<EpiStoreF32, pg8::StaticOrder, true, true>(lds, g, S, E);
    }
    GRID_BAR();
    for (int m = gw; m < M_; m += NGW)
        post_row<false>(a.out + (size_t)m * D_, Y + (size_t)m * D_, a.n_post_ffn, MOD + (m / T_) * 6144, 5120, a.out + (size_t)m * D_, nullptr, 0, 0, nullptr, lane);
}
}

extern "C" void kernel_launch(void* const* d_in, const int* in_sizes, int n_in, void* d_out, int out_size, void* d_ws, size_t ws_size, hipStream_t stream) {
    static int grid = 0;
    if (grid == 0) {
        if (n_in != 17 || in_sizes[0] != M_ * D_ || out_size != M_ * D_ || ws_size < WS_END) { fprintf(stderr, "kernel_launch: unexpected problem (n_in %d, ws %zu); nothing launched\n", n_in, ws_size); grid = -1; return; }
        int dev = 0, cus = 0, per_cu = 0;
        if (hipGetDevice(&dev) != hipSuccess || hipDeviceGetAttribute(&cus, hipDeviceAttributeMultiprocessorCount, dev) != hipSuccess) { grid = -1; return; }
        if (hipFuncSetAttribute((const void*)fwd_kernel, hipFuncAttributeMaxDynamicSharedMemorySize, LDS_BYTES) != hipSuccess) { fprintf(stderr, "kernel_launch: hipFuncSetAttribute failed\n"); grid = -1; return; }
        if (hipOccupancyMaxActiveBlocksPerMultiprocessor(&per_cu, (const void*)fwd_kernel, NTHR, LDS_BYTES) != hipSuccess || per_cu < 1) fprintf(stderr, "kernel_launch: occupancy query reports %d\n", per_cu);
        (void)hipGetLastError();
        grid = cus;
        if (grid != 256) fprintf(stderr, "kernel_launch: %d CUs (expected 256)\n", grid);
    }
    if (grid < 0) return;
    if (hipMemsetAsync((char*)d_ws + WS_CTL, 0, CTL_ZERO_BYTES, stream) != hipSuccess) return;
    Args a{};
    a.x = (const float*)d_in[0]; a.c = (const float*)d_in[1]; a.positions = (const int*)d_in[2]; a.w_ada = (const float*)d_in[3]; a.b_ada = (const float*)d_in[4];
    a.n_pre_mix = (const float*)d_in[5]; a.n_post_mix = (const float*)d_in[6]; a.n_pre_ffn = (const float*)d_in[7]; a.n_post_ffn = (const float*)d_in[8];
    a.w_in = (const float*)d_in[9]; a.lbraw = (const float*)d_in[10]; a.onorm = (const float*)d_in[11]; a.knw = (const float*)d_in[12]; a.knb = (const float*)d_in[13];
    a.w_out = (const float*)d_in[14]; a.w_ffn_in = (const float*)d_in[15]; a.w_ffn_out = (const float*)d_in[16];
    a.out = (float*)d_out; a.ws = (unsigned char*)d_ws;
    hipLaunchKernelGGL(fwd_kernel, dim3(grid), dim3(NTHR), LDS_BYTES, stream, a);
}
```

```cpp
#include <hip/hip_runtime.h>
#include <hip/hip_fp16.h>
#include <cstdio>
#include <cstdint>

namespace pg8 {
#define PG8_LAS __attribute__((address_space(3)))
typedef unsigned short h16_t;
typedef short bf16x8 __attribute__((ext_vector_type(8)));
typedef _Float16 half8 __attribute__((ext_vector_type(8)));
typedef float f32x4 __attribute__((ext_vector_type(4)));
typedef unsigned u32x4 __attribute__((ext_vector_type(4)));
constexpr int BM = 256, BK = 64, HALF = 128, HTB = HALF * BK * 2, STAGE_BYTES = 8 * HTB, NXCD = 8, WGM = 8;

__host__ __device__ __forceinline__ int lds_byte(int r, int c) { const int st = (r >> 4) * 2 + (c >> 5), rr = r & 15, cc = c & 31, ob = rr * 64 + cc * 2; return st * 1024 + (ob ^ (((ob >> 9) & 1) << 5)); }
__host__ __device__ __forceinline__ void stage_rc(int b, int& R, int& C) { const int st = b / 1024, sb = b % 1024, swz = sb ^ (((sb >> 9) & 1) << 5); R = (st >> 1) * 16 + swz / 64; C = (st & 1) * 32 + (swz % 64) / 2; }
__host__ __device__ __forceinline__ int perm32(int rho) { const int n = rho >> 4, i = rho & 15; return 8 * (i >> 2) + 4 * n + (i & 3); }

struct Unit { int pm, pn; };
struct Gemm { const h16_t* A; const h16_t* Bt; int M, N, K; };

struct StaticOrder {
    int nM, nN, nwg, G, c;
    __host__ __device__ void init(int M, int N, int G_, int c_) { nM = M / BM; nN = N / BM; nwg = nM * nN; G = G_; c = c_; }
    __host__ __device__ bool next(int i, Unit& u) const {
        const long L = (long)i * G + c; if (L >= nwg) return false;
        int wgid = (int)L; { const int q = nwg / NXCD, r = nwg % NXCD, xcd = wgid % NXCD, off = wgid / NXCD; wgid = (xcd < r ? xcd * (q + 1) : r * (q + 1) + (xcd - r) * q) + off; }
        const int nig = WGM * nN, gid = wgid / nig, fm = gid * WGM, gsz = (nM - fm) < WGM ? (nM - fm) : WGM;
        u.pm = fm + ((wgid % nig) % gsz); u.pn = (wgid % nig) / gsz; return true;
    }
    __device__ __forceinline__ void a_ready(const Unit&) const {}
    __device__ __forceinline__ void done(const Unit&) const {}
};

template <class Epi, class Sched, bool ALIGN_EPI = false, bool SP2 = false>
__device__ __forceinline__ void gemm_phase(PG8_LAS unsigned char* lds, const Gemm g, const Sched& S, const Epi& E) {
    int tid = threadIdx.x; asm volatile("" : "+v"(tid));
    const int wid = __builtin_amdgcn_readfirstlane(tid >> 6), lane = tid & 63, wr = wid >> 2, wc = wid & 3, fr = lane & 15, fq = lane >> 4;
    const int K = g.K, nt = K / BK;
    unsigned voffA[2], voffB[2];
#pragma unroll
    for (int i = 0; i < 2; ++i) { int R, C; stage_rc(tid * 16 + i * 8192, R, C); const int Rb = Epi::PERM ? ((R & ~31) + perm32(R & 31)) : R;
        voffA[i] = (unsigned)(R * K + C) * 2u; voffB[i] = (unsigned)(Rb * K + C) * 2u; }
    const size_t kstep = (size_t)(BK * 2);
    const size_t hstep = (size_t)HALF * K * 2;
    const size_t tstep = 2 * hstep;
    const unsigned ldsw = (unsigned)wid * 1024u;
    const int aoff = lds_byte(wr * 64 + fr, fq * 8), boff = lds_byte(wc * 32 + fr, fq * 8);
#define PG8_SA(b, h) (((b) * 2 + (h)) * HTB)
#define PG8_SB(b, h) ((4 + (b) * 2 + (h)) * HTB)
#define PG8_STAGE(bufoff, gbase, voff) do { _Pragma("unroll") for (int _i = 0; _i < 2; ++_i) \
        __builtin_amdgcn_global_load_lds((const unsigned*)((const char*)(gbase) + (voff)[_i]), (PG8_LAS unsigned*)(lds + (bufoff) + ldsw + _i * 8192), 16, 0, 0); } while (0)
#define PG8_LDA(dst, b, h) do { _Pragma("unroll") for (int m = 0; m < 4; ++m) _Pragma("unroll") for (int k = 0; k < 2; ++k) dst[m][k] = *(const PG8_LAS bf16x8*)(lds + PG8_SA(b, h) + aoff + m * 2048 + k * 1024); } while (0)
#define PG8_LDB(dst, b, h) do { _Pragma("unroll") for (int n = 0; n < 2; ++n) _Pragma("unroll") for (int k = 0; k < 2; ++k) dst[n][k] = *(const PG8_LAS bf16x8*)(lds + PG8_SB(b, h) + boff + n * 2048 + k * 1024); } while (0)
#define PG8_MMA(ai, bj, At, Bt) do { __builtin_amdgcn_s_setprio(1); _Pragma("unroll") for (int m = 0; m < 4; ++m) _Pragma("unroll") for (int n = 0; n < 2; ++n) _Pragma("unroll") for (int k = 0; k < 2; ++k) \
        acc[ai][bj][m][n] = __builtin_amdgcn_mfma_f32_16x16x32_f16(__builtin_bit_cast(half8, Bt[n][k]), __builtin_bit_cast(half8, At[m][k]), acc[ai][bj][m][n], 0, 0, 0); __builtin_amdgcn_s_setprio(0); } while (0)
#define PG8_WAIT_V(n) asm volatile("s_waitcnt vmcnt(" #n ")" ::: "memory")
#define PG8_WAIT_L(n) asm volatile("s_waitcnt lgkmcnt(" #n ")" ::: "memory")
#define PG8_BAR __builtin_amdgcn_s_barrier()
#define PG8_SCHED __builtin_amdgcn_sched_barrier(0)
    Unit cur, nxt; int ui = 0;
    if (!S.next(0, cur)) return;
    f32x4 acc[2][2][4][2];
#pragma unroll
    for (int a = 0; a < 2; ++a)
#pragma unroll
        for (int b = 0; b < 2; ++b)
#pragma unroll
            for (int m = 0; m < 4; ++m)
#pragma unroll
                for (int n = 0; n < 2; ++n) acc[a][b][m][n] = (f32x4){0.f, 0.f, 0.f, 0.f};
    bf16x8 At[4][2], B0[2][2], B1[2][2];
    const char* cA = (const char*)g.A + (size_t)cur.pm * tstep; const char* cB = (const char*)g.Bt + (size_t)cur.pn * tstep;
    S.a_ready(cur);
    if constexpr (SP2) {
        PG8_STAGE(PG8_SB(0, 0), cB, voffB); PG8_STAGE(PG8_SB(0, 1), cB + hstep, voffB); PG8_STAGE(PG8_SA(0, 0), cA, voffA); PG8_STAGE(PG8_SA(0, 1), cA + hstep, voffA);
        if (wr == 1) PG8_BAR;
        PG8_WAIT_V(2); PG8_BAR;
        PG8_STAGE(PG8_SB(1, 0), cB + kstep, voffB); PG8_STAGE(PG8_SA(1, 0), cA + kstep, voffA); PG8_STAGE(PG8_SB(1, 1), cB + hstep + kstep, voffB);
        PG8_WAIT_V(6); PG8_BAR;
    } else {
        PG8_STAGE(PG8_SB(0, 0), cB, voffB); PG8_STAGE(PG8_SA(0, 0), cA, voffA); PG8_STAGE(PG8_SB(0, 1), cB + hstep, voffB); PG8_STAGE(PG8_SA(0, 1), cA + hstep, voffA);
        if (wr == 1) PG8_BAR;
        PG8_WAIT_V(4); PG8_BAR;
        PG8_STAGE(PG8_SB(1, 0), cB + kstep, voffB); PG8_STAGE(PG8_SA(1, 0), cA + kstep, voffA); PG8_STAGE(PG8_SB(1, 1), cB + hstep + kstep, voffB);
        PG8_WAIT_V(6); PG8_BAR;
    }
    for (;;) {
        const bool has_next = S.next(ui + 1, nxt);
        const char* nA = has_next ? (const char*)g.A + (size_t)nxt.pm * tstep : cA; const char* nB = has_next ? (const char*)g.Bt + (size_t)nxt.pn * tstep : cB;
        for (int t = 0; t < nt; t += 2) {
            const bool last = (t == nt - 2);
            const char* a1 = cA + (size_t)(t + 1) * kstep;
            const char* a2 = last ? nA : cA + (size_t)(t + 2) * kstep; const char* b2 = last ? nB : cB + (size_t)(t + 2) * kstep;
            const char* a3 = a2 + kstep; const char* b3 = b2 + kstep;
            if (last && has_next) S.a_ready(nxt);
            if constexpr (SP2) {
            PG8_LDB(B0, 0, 0); PG8_LDB(B1, 0, 1); PG8_SCHED; PG8_LDA(At, 0, 0); PG8_STAGE(PG8_SA(1, 1), a1 + hstep, voffA);
            PG8_WAIT_V(8); PG8_WAIT_L(0); PG8_BAR; PG8_MMA(0, 0, At, B0); PG8_MMA(0, 1, At, B1); PG8_BAR; PG8_SCHED;
            PG8_LDA(At, 0, 1); PG8_STAGE(PG8_SB(0, 0), b2, voffB); PG8_STAGE(PG8_SB(0, 1), b2 + hstep, voffB); PG8_STAGE(PG8_SA(0, 0), a2, voffA);
            PG8_WAIT_V(8); PG8_WAIT_L(0); PG8_BAR; PG8_MMA(1, 0, At, B0); PG8_MMA(1, 1, At, B1); PG8_BAR; PG8_SCHED;
            PG8_LDB(B0, 1, 0); PG8_LDB(B1, 1, 1); PG8_SCHED; PG8_LDA(At, 1, 0); PG8_STAGE(PG8_SA(0, 1), a2 + hstep, voffA);
            PG8_WAIT_V(8); PG8_WAIT_L(0); PG8_BAR; PG8_MMA(0, 0, At, B0); PG8_MMA(0, 1, At, B1); PG8_BAR; PG8_SCHED;
            PG8_LDA(At, 1, 1); PG8_STAGE(PG8_SB(1, 0), b3, voffB); PG8_STAGE(PG8_SB(1, 1), b3 + hstep, voffB); PG8_STAGE(PG8_SA(1, 0), a3, voffA);
            PG8_WAIT_V(8); PG8_WAIT_L(0); PG8_BAR; PG8_MMA(1, 0, At, B0); PG8_MMA(1, 1, At, B1); PG8_BAR; PG8_SCHED;
            } else {
            PG8_LDB(B0, 0, 0); PG8_SCHED; PG8_LDA(At, 0, 0); PG8_STAGE(PG8_SA(1, 1), a1 + hstep, voffA);
            PG8_WAIT_L(8); PG8_BAR; PG8_WAIT_L(0); PG8_MMA(0, 0, At, B0); PG8_BAR; PG8_SCHED;
            PG8_LDB(B1, 0, 1); PG8_STAGE(PG8_SB(0, 0), b2, voffB);
            PG8_BAR; PG8_WAIT_L(0); PG8_MMA(0, 1, At, B1); PG8_BAR;
            PG8_LDA(At, 0, 1); PG8_STAGE(PG8_SA(0, 0), a2, voffA);
            PG8_BAR; PG8_WAIT_L(0); PG8_MMA(1, 0, At, B0); PG8_BAR; PG8_SCHED;
            PG8_STAGE(PG8_SB(0, 1), b2 + hstep, voffB);
            PG8_WAIT_V(6); PG8_BAR; PG8_MMA(1, 1, At, B1); PG8_BAR;
            PG8_LDB(B0, 1, 0); PG8_SCHED; PG8_LDA(At, 1, 0); PG8_STAGE(PG8_SA(0, 1), a2 + hstep, voffA);
            PG8_WAIT_L(8); PG8_BAR; PG8_WAIT_L(0); PG8_MMA(0, 0, At, B0); PG8_BAR; PG8_SCHED;
            PG8_LDB(B1, 1, 1); PG8_STAGE(PG8_SB(1, 0), b3, voffB);
            PG8_BAR; PG8_WAIT_L(0); PG8_MMA(0, 1, At, B1); PG8_BAR;
            PG8_LDA(At, 1, 1); PG8_STAGE(PG8_SA(1, 0), a3, voffA);
            PG8_BAR; PG8_WAIT_L(0); PG8_MMA(1, 0, At, B0); PG8_BAR; PG8_SCHED;
            PG8_STAGE(PG8_SB(1, 1), b3 + hstep, voffB);
            PG8_WAIT_V(6); PG8_BAR; PG8_MMA(1, 1, At, B1); PG8_BAR;
            }
        }
        if constexpr (ALIGN_EPI) { if (wr == 0) PG8_BAR; }
        if constexpr (!Epi::AFTER_DRAIN) { E(acc, cur, wr, wc, fr, fq); S.done(cur); }
        if (!has_next) break;
#pragma unroll
        for (int a = 0; a < 2; ++a)
#pragma unroll
            for (int b = 0; b < 2; ++b)
#pragma unroll
                for (int m = 0; m < 4; ++m)
#pragma unroll
                    for (int n = 0; n < 2; ++n) acc[a][b][m][n] = (f32x4){0.f, 0.f, 0.f, 0.f};
        cur = nxt; cA = nA; cB = nB; ++ui;
        if constexpr (ALIGN_EPI) { if (wr == 1) PG8_BAR; }
    }
    PG8_WAIT_V(0);
    if constexpr (!ALIGN_EPI) { if (wr == 0) PG8_BAR; }
    PG8_BAR;
#undef PG8_SA
#undef PG8_SB
#undef PG8_STAGE
#undef PG8_LDA
#undef PG8_LDB
#undef PG8_MMA
#undef PG8_WAIT_V
#undef PG8_WAIT_L
#undef PG8_BAR
#undef PG8_SCHED
}
}

namespace att {
constexpr int D = 128, LDQ = 512, LDO = 1024;
constexpr int NW = 8, QBLK = 32, KVBLK = 64, QB = NW * QBLK;
constexpr int SHM_V = KVBLK * D * 2, SHM_K = KVBLK * D * 2;
constexpr int LDS_ATT = 2 * SHM_V + 2 * SHM_K + NW * 64 * 4;
constexpr float THR = 8.f;
typedef unsigned short h16;
typedef short hx8 __attribute__((ext_vector_type(8)));
typedef _Float16 half8 __attribute__((ext_vector_type(8)));
typedef short s16x4 __attribute__((ext_vector_type(4)));
typedef float f32x16 __attribute__((ext_vector_type(16)));
typedef float f32x4 __attribute__((ext_vector_type(4)));
typedef unsigned u32x4 __attribute__((ext_vector_type(4)));
typedef unsigned long long u64;
#define KSWZ(row, colB) ((row) * 256 + ((colB) ^ (((row) & 7) << 4)))
#define SBAR() __builtin_amdgcn_sched_barrier(0)
#define MFMA32(a, b, c) __builtin_amdgcn_mfma_f32_32x32x16_f16(__builtin_bit_cast(half8, a), __builtin_bit_cast(half8, b), c, 0, 0, 0)
__device__ __forceinline__ int v_st(int k, int c) { const int kk = (k & ~0xC) | ((k & 4) << 1) | ((k & 8) >> 1); return ((kk >> 3) * 4 + (c >> 5)) * 512 + ((kk & 7) * 32 + (c & 31)) * 2; }
__device__ __forceinline__ int v_rd_base(int lane) { return ((lane & 3) << 3) | (((lane >> 2) & 3) << 6) | (((lane >> 4) & 1) << 5) | (((lane >> 5) & 1) << 8); }
constexpr int v_rd_off(int d0, int ks, int half) { return d0 * 512 + ks * 4096 + half * 2048; }
__device__ __forceinline__ int crow(int r, int hi) { return (r & 3) + 8 * (r >> 2) + 4 * hi; }
__device__ __forceinline__ unsigned cvtpk(float lo, float hi) {
    typedef _Float16 h2 __attribute__((ext_vector_type(2))); typedef float f2 __attribute__((ext_vector_type(2)));
    const h2 h = __builtin_convertvector((f2){lo, hi}, h2); return __builtin_bit_cast(unsigned, h);
}
__device__ __forceinline__ hx8 load8(const h16* p) { return *reinterpret_cast<const hx8*>(p); }
__device__ __forceinline__ void mask_bits(f32x16& p0, f32x16& p1, u64 mw, int hi) {
    const float NEG = -__builtin_inff();
    const unsigned lo = (unsigned)mw >> (4 * hi), hh = (unsigned)(mw >> 32) >> (4 * hi);
#pragma unroll
    for (int r = 0; r < 16; ++r) {
        const int c = (r & 3) + 8 * (r >> 2);
        if (!((lo >> c) & 1u)) p0[r] = NEG;
        if (!((hh >> c) & 1u)) p1[r] = NEG;
    }
}
__device__ __forceinline__ void partialSM(f32x16& p0, f32x16& p1, float& m_reg, float& mn, float& alpha) {
    float pmax = p0[0]; for (int r = 1; r < 16; ++r) pmax = fmaxf(pmax, p0[r]); for (int r = 0; r < 16; ++r) pmax = fmaxf(pmax, p1[r]);
    { auto rr = __builtin_amdgcn_permlane32_swap(__float_as_uint(pmax), __float_as_uint(pmax), false, false);
      pmax = fmaxf(__uint_as_float(rr[0]), __uint_as_float(rr[1])); }
    constexpr float C2 = 1.4426950408889634f;
    if (__builtin_expect(__all((pmax - m_reg) <= THR), 1)) { mn = m_reg; alpha = 1.f; }
    else { mn = fmaxf(m_reg, pmax); alpha = __builtin_amdgcn_exp2f((m_reg - mn) * C2); m_reg = mn; }
    const float mnL = -mn * C2;
    for (int r = 0; r < 16; ++r) p0[r] = fmaf(p0[r], C2, mnL); for (int r = 0; r < 16; ++r) p1[r] = fmaf(p1[r], C2, mnL);
    for (int r = 0; r < 16; ++r) p0[r] = __builtin_amdgcn_exp2f(p0[r]);
}
__device__ __forceinline__ void finishSM(f32x16& p0, f32x16& p1, float alpha, float& l_reg, hx8& pa0, hx8& pa1, hx8& pa2, hx8& pa3) {
    for (int r = 0; r < 16; ++r) p1[r] = __builtin_amdgcn_exp2f(p1[r]);
    float ps = 0; for (int r = 0; r < 16; ++r) ps += p0[r]; for (int r = 0; r < 16; ++r) ps += p1[r];
    { auto rr = __builtin_amdgcn_permlane32_swap(__float_as_uint(ps), __float_as_uint(ps), false, false);
      ps = __uint_as_float(rr[0]) + __uint_as_float(rr[1]); }
    l_reg = l_reg * alpha + ps;
#define PK4(P, B_, OUT) do { unsigned a0 = cvtpk(P[B_+0], P[B_+1]), a1 = cvtpk(P[B_+2], P[B_+3]);                          \
        unsigned b0 = cvtpk(P[B_+4], P[B_+5]), b1 = cvtpk(P[B_+6], P[B_+7]);                                             \
        auto r0 = __builtin_amdgcn_permlane32_swap(a0, b0, false, false); auto r1 = __builtin_amdgcn_permlane32_swap(a1, b1, false, false); \
        u32x4 w = {r0[0], r1[0], r0[1], r1[1]}; OUT = *reinterpret_cast<hx8*>(&w); } while (0)
    PK4(p0, 0, pa0); PK4(p0, 8, pa1); PK4(p1, 0, pa2); PK4(p1, 8, pa3);
#undef PK4
}
template <int KB>
__device__ __forceinline__ void qkt(f32x16& p0, f32x16& p1, const char* K_lds, int r32, int hi, const hx8* qr) {
    p0 = f32x16{}; p1 = f32x16{};
    const char* kb[4];
#pragma unroll
    for (int dd = 0; dd < 4; ++dd) kb[dd] = K_lds + KB * SHM_K + KSWZ(r32, (dd * 16 + hi * 8) * 2);
#pragma unroll
    for (int d0 = 0; d0 < 8; ++d0) { const char* a = kb[d0 & 3] + (d0 >> 2) * 128;
        hx8 b0 = *reinterpret_cast<const hx8*>(a);
        hx8 b1 = *reinterpret_cast<const hx8*>(a + 32 * 256);
        p0 = MFMA32(b0, qr[d0], p0);
        p1 = MFMA32(b1, qr[d0], p1); }
}
template <int VB>
__device__ __forceinline__ void pv_tile(f32x16* o, int vb0, hx8 pa0, hx8 pa1, hx8 pa2, hx8 pa3) {
#define TRRD(dst, off) asm volatile("ds_read_b64_tr_b16 %0, %1 offset:%2" : "=&v"(dst) : "v"(vb0), "i"(off) : "memory")
#define PV_D0(d0) do { s16x4 l0, l1, l2, l3, h0, h1, h2, h3; constexpr int b_ = VB * SHM_V + v_rd_off(d0, 0, 0); \
        TRRD(l0, b_); TRRD(h0, b_ + 2048); TRRD(l1, b_ + 4096); TRRD(h1, b_ + 6144); TRRD(l2, b_ + 8192); TRRD(h2, b_ + 10240); TRRD(l3, b_ + 12288); TRRD(h3, b_ + 14336); \
        asm volatile("s_waitcnt lgkmcnt(0)" ::: "memory"); SBAR();   \
        o[d0] = MFMA32(pa0, ((hx8){l0[0], l0[1], l0[2], l0[3], h0[0], h0[1], h0[2], h0[3]}), o[d0]);   \
        o[d0] = MFMA32(pa1, ((hx8){l1[0], l1[1], l1[2], l1[3], h1[0], h1[1], h1[2], h1[3]}), o[d0]);   \
        o[d0] = MFMA32(pa2, ((hx8){l2[0], l2[1], l2[2], l2[3], h2[0], h2[1], h2[2], h2[3]}), o[d0]);   \
        o[d0] = MFMA32(pa3, ((hx8){l3[0], l3[1], l3[2], l3[3], h3[0], h3[1], h3[2], h3[3]}), o[d0]); } while (0)
    PV_D0(0); PV_D0(1); PV_D0(2); PV_D0(3);
#undef PV_D0
#undef TRRD
}
struct BlockRef { const h16* Q; const h16* K; const h16* V; h16* O; const u64* MK; int P0; };
struct Seam { hx8 qr[8]; hx8 st_v0, st_v1, st_k0, st_k1; };
#define ROW(p, k0, rr) ((p) + (size_t)((k0) + (rr)) * LDQ + sc)
#define VMW() asm volatile("s_waitcnt vmcnt(0)" ::: "memory")
#define VMWN(n) asm volatile("s_waitcnt vmcnt(%0)" :: "i"(n) : "memory")
#define SLOAD_H(Kp, Vp, k0) do { S.st_v0 = load8(ROW(Vp, k0, sr)); S.st_v1 = load8(ROW(Vp, k0, 32 + sr));              \
                         S.st_k0 = load8(ROW(Kp, k0, sr)); S.st_k1 = load8(ROW(Kp, k0, 32 + sr)); } while (0)
#define SWRITE_HK(bf) do { *(hx8*)(K_lds + (bf) * SHM_K + kws) = S.st_k0; *(hx8*)(K_lds + (bf) * SHM_K + kws + 32 * 256) = S.st_k1; } while (0)
#define SWRITE_HV(bf) do { *(hx8*)(V_lds + (bf) * SHM_V + vst0) = S.st_v0; *(hx8*)(V_lds + (bf) * SHM_V + vst1) = S.st_v1; } while (0)
#define SWRITE_H(bf) do { SWRITE_HV(bf); SWRITE_HK(bf); } while (0)
__device__ __forceinline__ void prime(const BlockRef& cur, char* lds, Seam& S) {
    const int tid = threadIdx.x, wid = __builtin_amdgcn_readfirstlane(tid >> 6), lane = tid & 63, r32 = lane & 31, hi = lane >> 5;
    const int sr = tid >> 4, sc = (tid & 15) * 8, kws = KSWZ(sr, sc * 2); char* K_lds = lds + 2 * SHM_V;
    for (int d0 = 0; d0 < 8; ++d0) S.qr[d0] = load8(cur.Q + (size_t)(wid * QBLK + r32) * LDQ + d0 * 16 + hi * 8);
    SLOAD_H(cur.K, cur.V, 0); VMW(); SWRITE_HK(0);
    __syncthreads();
}
__device__ __forceinline__ void block(const BlockRef& cur, const BlockRef& nxt, char* lds, Seam& S) {
    int tid = threadIdx.x; asm volatile("" : "+v"(tid));
    const int wid = __builtin_amdgcn_readfirstlane(tid >> 6), lane = tid & 63, r32 = lane & 31, hi = lane >> 5;
    const int NT = (cur.P0 + QB) / KVBLK;
    char* V_lds = lds; char* K_lds = lds + 2 * SHM_V;
    float* ws = (float*)(lds + 2 * SHM_V + 2 * SHM_K) + wid * 64; float* li_l = ws, * al_l = ws + 32;
    float m_reg = -1e30f, l_reg = 0; f32x16 o[4] = {};
    const int sr = tid >> 4, sc = (tid & 15) * 8, vst0 = v_st(sr, sc), vst1 = v_st(32 + sr, sc), kws = KSWZ(sr, sc * 2);
    const int vb0 = (int)(uintptr_t)V_lds + v_rd_base(lane);
    const h16* Kh = cur.K; const h16* Vh = cur.V;
    const u64* mkp = cur.MK + wid * QBLK + r32;
#define RESC(a) do { if (__any((a) < 1.f)) { if (hi == 0) al_l[r32] = (a); asm volatile("s_waitcnt lgkmcnt(0)" ::: "memory");              \
                     for (int d_ = 0; d_ < 4; ++d_) for (int r = 0; r < 16; ++r) o[d_][r] *= al_l[crow(r, hi)]; } } while (0)
#define KBASE(t) ((t) * KVBLK)
#define MLOAD(t) (mkp[(size_t)(t) * 8192])
    f32x16 pA0, pA1, pB0, pB1; float mnA, mnB, alA, alB; hx8 pa0, pa1, pa2, pa3; u64 mwA, mwB;
    SWRITE_HV(0); SBAR();
    mwA = MLOAD(0);
    if (NT > 1) { SLOAD_H(Kh, Vh, KBASE(1)); }
    SBAR(); qkt<0>(pA0, pA1, K_lds, r32, hi, S.qr);
    mask_bits(pA0, pA1, mwA, hi); partialSM(pA0, pA1, m_reg, mnA, alA);
    if (NT > 1) { VMW(); SWRITE_H(1); }
    __syncthreads();
#define HALF_STEP(PX0, PX1, mnX, alX, mwX, PY0, PY1, alY, t, KB, VB, SB) do {                                                      \
        SBAR(); mwX = MLOAD(t); qkt<KB>(PX0, PX1, K_lds, r32, hi, S.qr);                                             \
        finishSM(PY0, PY1, alY, l_reg, pa0, pa1, pa2, pa3); SBAR();                                                           \
        if ((t) + 1 < NT) { SLOAD_H(Kh, Vh, KBASE((t) + 1)); SBAR(); }                                               \
        pv_tile<VB>(o, vb0, pa0, pa1, pa2, pa3); mask_bits(PX0, PX1, mwX, hi); partialSM(PX0, PX1, m_reg, mnX, alX);                                        \
        __syncthreads();                                                                                                      \
        if ((t) + 1 < NT) { VMW(); SWRITE_H(SB); }                                                                          \
        RESC(alX); __syncthreads(); } while (0)
    for (int t = 1; t + 1 < NT; t += 2) {
        HALF_STEP(pB0, pB1, mnB, alB, mwB, pA0, pA1, alA, t, 1, 0, 0);
        HALF_STEP(pA0, pA1, mnA, alA, mwA, pB0, pB1, alB, t + 1, 0, 1, 1);
    }
    const bool even = (NT & 1) == 0;
    if (even) { SBAR(); mwB = MLOAD(NT - 1); qkt<1>(pB0, pB1, K_lds, r32, hi, S.qr); SBAR(); }
    SLOAD_H(nxt.K, nxt.V, 0); SBAR();
#pragma unroll
    for (int d0 = 0; d0 < 8; ++d0) S.qr[d0] = load8(nxt.Q + (size_t)(wid * QBLK + r32) * LDQ + d0 * 16 + hi * 8);
    SBAR();
    finishSM(pA0, pA1, alA, l_reg, pa0, pa1, pa2, pa3); SBAR();
    pv_tile<0>(o, vb0, pa0, pa1, pa2, pa3);
    if (even) { mask_bits(pB0, pB1, mwB, hi); partialSM(pB0, pB1, m_reg, mnB, alB); __syncthreads(); RESC(alB);
        finishSM(pB0, pB1, alB, l_reg, pa0, pa1, pa2, pa3); SBAR(); pv_tile<1>(o, vb0, pa0, pa1, pa2, pa3); }
    SBAR(); VMWN(8); SWRITE_HK(0); SBAR();
    if (hi == 0) li_l[r32] = l_reg; asm volatile("s_waitcnt lgkmcnt(0)" ::: "memory");
    float rli[16];
#pragma unroll
    for (int r = 0; r < 16; ++r) rli[r] = __builtin_amdgcn_rcpf(li_l[crow(r, hi)]);
    h16* Ow = cur.O + (size_t)(wid * QBLK) * LDO;
#pragma unroll
    for (int r = 0; r < 16; ++r) { const int orow = crow(r, hi);
#pragma unroll
        for (int d0 = 0; d0 < 4; ++d0) { const float v = o[d0][r] * rli[r];
            const float vn = __shfl_xor(v, 1);
            if ((r32 & 1) == 0) *(unsigned*)(Ow + (size_t)orow * LDO + d0 * 32 + r32) = cvtpk(v, vn); } }
    __syncthreads();
#undef RESC
#undef KBASE
#undef MLOAD
#undef HALF_STEP
}
#undef ROW
#undef VMW
#undef VMWN
#undef SLOAD_H
#undef SWRITE_HK
#undef SWRITE_HV
#undef SWRITE_H
#undef KSWZ
#undef SBAR
#undef MFMA32
}

namespace idx {
typedef unsigned short h16;
typedef short hx8 __attribute__((ext_vector_type(8)));
typedef _Float16 half8 __attribute__((ext_vector_type(8)));
typedef float f32x16 __attribute__((ext_vector_type(16)));
typedef __attribute__((address_space(3))) unsigned lds_u32;
constexpr int T = 8192, CAP = 512, TRIG = CAP - 32, WAVE_LDS = 8 * CAP * 4 + 256;
__device__ __forceinline__ unsigned tokey(float f) { const unsigned u = __float_as_uint(f); return (u & 0x80000000u) ? ~u : (u | 0x80000000u); }
__device__ __forceinline__ void lds_wait() { asm volatile("s_waitcnt lgkmcnt(0)" ::: "memory"); }

__device__ __forceinline__ unsigned radix_level(const unsigned (&keys)[8], unsigned alive, lds_u32* hist, int lane, int shift, unsigned dmask, int& K) {
    hist[lane] = 0u; lds_wait();
#pragma unroll
    for (int j = 0; j < 8; ++j) if ((alive >> j) & 1u) __hip_atomic_fetch_add((unsigned*)(hist + ((keys[j] >> shift) & dmask)), 1u, __ATOMIC_RELAXED, __HIP_MEMORY_SCOPE_WORKGROUP);
    lds_wait();
    unsigned suf = hist[lane];
#pragma unroll
    for (int o = 1; o < 64; o <<= 1) { const unsigned v = __shfl_down(suf, o); if (lane + o < 64) suf += v; }
    const unsigned long long bal = __ballot(suf >= (unsigned)K);
    const int d = __builtin_amdgcn_readfirstlane(63 - __builtin_clzll(bal | 1ull));
    const unsigned above = (d < 63) ? (unsigned)__builtin_amdgcn_readlane((int)suf, d + 1) : 0u;
    K -= (int)above;
    return (unsigned)d;
}
template <int NLEV>
__device__ __forceinline__ unsigned wave_select(const unsigned (&keys)[8], unsigned valid, lds_u32* hist, int lane, int& K) {
    unsigned prefix = 0u;
#pragma unroll
    for (int lv = 0; lv < NLEV; ++lv) {
        const int shift = lv == 0 ? 26 : lv == 1 ? 20 : lv == 2 ? 14 : lv == 3 ? 8 : lv == 4 ? 2 : 0, bits = lv == 5 ? 2 : 6;
        unsigned alive = valid;
        if (lv > 0) {
#pragma unroll
            for (int j = 0; j < 8; ++j) if ((keys[j] >> (shift + bits)) != prefix) alive &= ~(1u << j);
        }
        const unsigned d = radix_level(keys, alive, hist, lane, shift, (1u << bits) - 1u, K);
        prefix = (prefix << bits) | d;
    }
    return prefix;
}
__device__ __forceinline__ void load_buf(const lds_u32* bufq, int n, int lane, unsigned (&keys)[8], unsigned& valid) {
    valid = 0u;
#pragma unroll
    for (int j = 0; j < 8; ++j) { const int i = lane + 64 * j; if (i < n) { keys[j] = bufq[i]; valid |= 1u << j; } else keys[j] = 0u; }
    lds_wait();
}
__device__ __forceinline__ void compact(lds_u32* bufq, lds_u32* hist, int n, int lane, int& ncnt, unsigned& ntau) {
    unsigned keys[8], valid; load_buf(bufq, n, lane, keys, valid);
    int K = 256;
    const unsigned P = wave_select<3>(keys, valid, hist, lane, K);
    const unsigned tauq = P << 14;
    int base = 0;
#pragma unroll
    for (int j = 0; j < 8; ++j) {
        const bool keep = ((valid >> j) & 1u) && keys[j] >= tauq;
        const unsigned long long m = __ballot(keep);
        const int pos = base + (int)__builtin_amdgcn_mbcnt_hi((unsigned)(m >> 32), __builtin_amdgcn_mbcnt_lo((unsigned)m, 0u));
        if (keep) bufq[pos] = keys[j];
        base += __builtin_popcountll(m);
    }
    lds_wait();
    ncnt = base; ntau = tauq ? tauq - 1u : 0u;
    if (base > TRIG) {
        load_buf(bufq, base, lane, keys, valid);
        int K2 = 256;
        const unsigned tau = wave_select<6>(keys, valid, hist, lane, K2);
        int b2 = 0, eqleft = K2;
#pragma unroll
        for (int j = 0; j < 8; ++j) {
            const bool v = (valid >> j) & 1u;
            const bool gt = v && keys[j] > tau, eq = v && keys[j] == tau;
            const unsigned long long me = __ballot(eq);
            const int erank = (int)__builtin_amdgcn_mbcnt_hi((unsigned)(me >> 32), __builtin_amdgcn_mbcnt_lo((unsigned)me, 0u));
            const bool keep = gt || (eq && erank < eqleft);
            const unsigned long long m = __ballot(keep);
            const int pos = b2 + (int)__builtin_amdgcn_mbcnt_hi((unsigned)(m >> 32), __builtin_amdgcn_mbcnt_lo((unsigned)m, 0u));
            if (keep) bufq[pos] = keys[j];
            b2 += __builtin_popcountll(m);
            const int ne = __builtin_popcountll(me); eqleft = eqleft > ne ? eqleft - ne : 0;
        }
        lds_wait();
        ncnt = b2; ntau = tau;
    }
}

__device__ __forceinline__ void select_task(int task, __attribute__((address_space(3))) unsigned char* wl, const h16* __restrict__ IQ, const h16* __restrict__ IK,
                                            const float* __restrict__ IW, unsigned* __restrict__ MASK32, int lane) {
    lds_u32* buf = (lds_u32*)wl; lds_u32* hist = (lds_u32*)(wl + 8 * CAP * 4);
    const int b = task >> 10, i = task & 1023, c = lane & 31, hi = lane >> 5;
    const int qp0 = 4 * i, qp1 = 8188 - 4 * i;
    hx8 af[2][4]; float wv[2][2][8]; int tq[2][2];
    {
        const int rho = c, qloc = 2 * ((rho >> 2) & 1) + (rho >> 4), head = (rho & 3) + 4 * ((rho >> 3) & 1);
#pragma unroll
        for (int g = 0; g < 2; ++g) {
            const int qp = g ? qp1 : qp0;
#pragma unroll
            for (int ks = 0; ks < 4; ++ks) af[g][ks] = *(const hx8*)(IQ + ((size_t)(b * T + qp + qloc)) * 512 + head * 64 + ks * 16 + 8 * hi);
#pragma unroll
            for (int e = 0; e < 2; ++e) {
                tq[g][e] = qp + 2 * hi + e;
#pragma unroll
                for (int h = 0; h < 8; ++h) wv[g][e][h] = IW[((size_t)(b * T + qp + 2 * hi + e)) * 8 + h];
            }
        }
    }
    const int ntiles = (qp1 + 3) / 32 + 1, lo_tiles = (qp0 + 3) / 32 + 1;
    const h16* kp = IK + ((size_t)b * T + c) * 64 + 8 * hi;
    unsigned tau[2][2] = {{0u, 0u}, {0u, 0u}}; int cnt[2][2] = {{0, 0}, {0, 0}}; int req[2][2] = {{0, 0}, {0, 0}}, eqs[2][2] = {{0, 0}, {0, 0}};
#define IDX_SCORES(g) \
            f32x16 acc = {}; \
            _Pragma("unroll") for (int ks = 0; ks < 4; ++ks) acc = __builtin_amdgcn_mfma_f32_32x32x16_f16(__builtin_bit_cast(half8, af[g][ks]), __builtin_bit_cast(half8, bf[ks]), acc, 0, 0, 0); \
            float sc[2] = {0.f, 0.f}; \
            _Pragma("unroll") for (int h = 0; h < 8; ++h) { sc[0] = fmaf(wv[g][0][h], fmaxf(acc[h], 0.f), sc[0]); sc[1] = fmaf(wv[g][1][h], fmaxf(acc[8 + h], 0.f), sc[1]); } \
            if (sc[0] == 0.f) sc[0] = 0.f; if (sc[1] == 0.f) sc[1] = 0.f;
    {
        hx8 bf[4];
#pragma unroll
        for (int ks = 0; ks < 4; ++ks) bf[ks] = *(const hx8*)(kp + ks * 16);
        for (int jt = 0; jt < ntiles; ++jt) {
            hx8 bn[4];
            { const int jn = jt + 1 < ntiles ? jt + 1 : jt;
#pragma unroll
              for (int ks = 0; ks < 4; ++ks) bn[ks] = *(const hx8*)(kp + (size_t)jn * 32 * 64 + ks * 16); }
            const int sidx = jt * 32 + c;
#pragma unroll
            for (int g = 0; g < 2; ++g) {
                if (g == 0 && jt >= lo_tiles) continue;
                IDX_SCORES(g)
#pragma unroll
                for (int e = 0; e < 2; ++e) {
                    const unsigned key = tokey(sc[e]);
                    const bool pass = sidx <= tq[g][e] && key > tau[g][e];
                    const unsigned long long m = __ballot(pass);
                    if (m) {
                        const unsigned mlo = (unsigned)m, mhi = (unsigned)(m >> 32);
                        const int pre = hi ? (int)__builtin_amdgcn_mbcnt_hi(mhi, 0u) : (int)__builtin_amdgcn_mbcnt_lo(mlo, 0u);
                        if (pass) buf[(g * 4 + 2 * hi + e) * CAP + cnt[g][e] + pre] = key;
                        cnt[g][e] += hi ? __builtin_popcount(mhi) : __builtin_popcount(mlo);
                        if (__ballot(cnt[g][e] > TRIG)) {
                            lds_wait();
#pragma unroll
                            for (int hf = 0; hf < 2; ++hf) {
                                const int n = __builtin_amdgcn_readlane(cnt[g][e], 32 * hf);
                                if (n > TRIG) {
                                    int ncnt; unsigned ntau;
                                    compact(buf + (g * 4 + 2 * hf + e) * CAP, hist, n, lane, ncnt, ntau);
                                    if (hi == hf) { cnt[g][e] = ncnt; tau[g][e] = ntau; }
                                }
                            }
                        }
                    }
                }
            }
#pragma unroll
            for (int ks = 0; ks < 4; ++ks) bf[ks] = bn[ks];
        }
    }
    lds_wait();
#pragma unroll
    for (int g = 0; g < 2; ++g)
#pragma unroll
        for (int e = 0; e < 2; ++e)
#pragma unroll
            for (int hf = 0; hf < 2; ++hf) {
                const int n = __builtin_amdgcn_readlane(cnt[g][e], 32 * hf), tqq = __builtin_amdgcn_readlane(tq[g][e], 32 * hf);
                unsigned ft = 0u; int fr = 0;
                if (tqq >= 256) {
                    unsigned keys[8], valid; load_buf(buf + (g * 4 + 2 * hf + e) * CAP, n, lane, keys, valid);
                    int K = 256;
                    ft = wave_select<6>(keys, valid, hist, lane, K); fr = K;
                }
                if (hi == hf) { tau[g][e] = ft; req[g][e] = fr; }
            }
    {
        hx8 bf[4];
#pragma unroll
        for (int ks = 0; ks < 4; ++ks) bf[ks] = *(const hx8*)(kp + ks * 16);
        for (int jt = 0; jt < ntiles; ++jt) {
            hx8 bn[4];
            { const int jn = jt + 1 < ntiles ? jt + 1 : jt;
#pragma unroll
              for (int ks = 0; ks < 4; ++ks) bn[ks] = *(const hx8*)(kp + (size_t)jn * 32 * 64 + ks * 16); }
            const int sidx = jt * 32 + c;
#pragma unroll
            for (int g = 0; g < 2; ++g) {
                if (g == 0 && jt >= lo_tiles) continue;
                IDX_SCORES(g)
#pragma unroll
                for (int e = 0; e < 2; ++e) {
                    const unsigned key = tokey(sc[e]);
                    const bool valid = sidx <= tq[g][e];
                    bool sel = valid && key > tau[g][e];
                    const bool eq = valid && key == tau[g][e];
                    const unsigned long long me = __ballot(eq);
                    if (me) {
                        const unsigned elo = (unsigned)me, ehi = (unsigned)(me >> 32);
                        const int er = eqs[g][e] + (hi ? (int)__builtin_amdgcn_mbcnt_hi(ehi, 0u) : (int)__builtin_amdgcn_mbcnt_lo(elo, 0u));
                        sel = sel || (eq && er < req[g][e]);
                        eqs[g][e] += hi ? __builtin_popcount(ehi) : __builtin_popcount(elo);
                    }
                    const unsigned long long ms = __ballot(sel);
                    if (c == 0 && jt * 32 <= tq[g][e])
                        MASK32[(((size_t)(b * 128 + (jt >> 1))) * 8192 + tq[g][e]) * 2 + (jt & 1)] = hi ? (unsigned)(ms >> 32) : (unsigned)ms;
                }
            }
#pragma unroll
            for (int ks = 0; ks < 4; ++ks) bf[ks] = bn[ks];
        }
    }
#undef IDX_SCORES
}
}

namespace hg {
typedef unsigned short h16;
typedef short hx8 __attribute__((ext_vector_type(8)));
typedef _Float16 half8 __attribute__((ext_vector_type(8)));
typedef float f32x16 __attribute__((ext_vector_type(16)));
typedef unsigned u32x4 __attribute__((ext_vector_type(4)));
typedef __attribute__((address_space(3))) unsigned char lds_u8;
constexpr int T = 8192, LDP = 136, LDS_S = 72;
constexpr int OFF_PART = 0, OFF_VT = 2048, OFF_KST = 20480;
constexpr int OFF_QIN = 20480, OFF_QD = 37888, OFF_KD = 55296, OFF_QO = 72704, OFF_KO = 81408, OFF_A = 90112, OFF_O = 99328;
__device__ __forceinline__ float h2f(h16 v) { return (float)__builtin_bit_cast(_Float16, v); }
__device__ __forceinline__ h16 f2h(float v) { return __builtin_bit_cast(h16, (_Float16)v); }
__device__ __forceinline__ h16 f2bf(float f) { const unsigned u = __float_as_uint(f); return (h16)((u + 0x7fffu + ((u >> 16) & 1u)) >> 16); }
__device__ __forceinline__ int crow(int r, int hi) { return (r & 3) + 8 * (r >> 2) + 4 * hi; }
#define HG_MFMA_F16(a, b, c) __builtin_amdgcn_mfma_f32_32x32x16_f16(__builtin_bit_cast(half8, a), __builtin_bit_cast(half8, b), c, 0, 0, 0)
#define HG_MFMA_BF16(a, b, c) __builtin_amdgcn_mfma_f32_32x32x16_bf16(a, b, c, 0, 0, 0)

__device__ __forceinline__ void head(lds_u8* lds, const h16* __restrict__ LF, const h16* __restrict__ V, size_t row0, int col0, int tid, float (&lf)[16], float (&g)[16], float (&ps)[4]) {
    const int k = tid & 127, p = tid >> 7;
    __attribute__((address_space(3))) float* part = (__attribute__((address_space(3))) float*)(lds + OFF_PART);
    __attribute__((address_space(3))) h16* vT = (__attribute__((address_space(3))) h16*)(lds + OFF_VT);
    float run = 0.f;
#pragma unroll
    for (int i = 0; i < 16; ++i) { lf[i] = h2f(LF[(row0 + 16 * p + i) * 512 + col0 + k]); run += lf[i]; g[i] = run; }
    part[p * 128 + k] = run;
#pragma unroll
    for (int u = 0; u < 2; ++u) {
        const int idx = tid + 512 * u, sidx = idx >> 4, d8 = (idx & 15) * 8;
        const u32x4 w = *(const u32x4*)(V + (row0 + sidx) * 512 + col0 + d8);
        const unsigned ww[4] = {w.x, w.y, w.z, w.w};
#pragma unroll
        for (int e = 0; e < 4; ++e) { vT[(d8 + 2 * e) * LDS_S + sidx] = (h16)(ww[e] & 0xffff); vT[(d8 + 2 * e + 1) * LDS_S + sidx] = (h16)(ww[e] >> 16); }
    }
    __syncthreads();
#pragma unroll
    for (int q = 0; q < 4; ++q) ps[q] = part[q * 128 + k];
    float off = 0.f;
#pragma unroll
    for (int q = 0; q < 4; ++q) if (q < p) off += ps[q];
#pragma unroll
    for (int i = 0; i < 16; ++i) g[i] += off;
}

__device__ __forceinline__ void h1_task(int task, lds_u8* lds, const h16* __restrict__ LF, const h16* __restrict__ V, h16* __restrict__ UST, float* __restrict__ DEC) {
    int tid = threadIdx.x; asm volatile("" : "+v"(tid));
    const int lane = tid & 63, wave = __builtin_amdgcn_readfirstlane(tid >> 6), r = lane & 31, hi = lane >> 5;
    const int bh = task >> 7, c = task & 127, b = bh >> 2, h = bh & 3, k = tid & 127, p = tid >> 7;
    const size_t row0 = (size_t)b * T + c * 64; const int col0 = h * 128;
    float lf[16], g[16], ps[4];
    head(lds, LF, V, row0, col0, tid, lf, g, ps);
    const float gtot = (ps[0] + ps[1]) + (ps[2] + ps[3]);
    __attribute__((address_space(3))) h16* kst = (__attribute__((address_space(3))) h16*)(lds + OFF_KST);
    {
        unsigned w[8];
#pragma unroll
        for (int i = 0; i < 16; i += 2) {
            const float a0 = (1.f - __expf(lf[i])) * __expf(gtot - g[i]), a1 = (1.f - __expf(lf[i + 1])) * __expf(gtot - g[i + 1]);
            w[i >> 1] = (unsigned)f2h(a0) | ((unsigned)f2h(a1) << 16);
        }
        __attribute__((address_space(3))) u32x4* dst = (__attribute__((address_space(3))) u32x4*)(kst + k * LDS_S + 16 * p);
        dst[0] = (u32x4){w[0], w[1], w[2], w[3]}; dst[1] = (u32x4){w[4], w[5], w[6], w[7]};
    }
    if (p == 0) DEC[(size_t)task * 128 + k] = __expf(gtot);
    __syncthreads();
    const __attribute__((address_space(3))) h16* vT = (const __attribute__((address_space(3))) h16*)(lds + OFF_VT);
    const int vi = wave >> 1;
#pragma unroll
    for (int tt = 0; tt < 2; ++tt) {
        const int kj = (wave & 1) * 2 + tt;
        f32x16 acc = {};
#pragma unroll
        for (int ks = 0; ks < 4; ++ks) {
            const hx8 af = *(const __attribute__((address_space(3))) hx8*)(vT + (32 * vi + r) * LDS_S + ks * 16 + 8 * hi);
            const hx8 bf = *(const __attribute__((address_space(3))) hx8*)(kst + (32 * kj + r) * LDS_S + ks * 16 + 8 * hi);
            acc = HG_MFMA_F16(af, bf, acc);
        }
        h16* dst = UST + ((size_t)task * 128 + 32 * vi) * 128 + 32 * kj + r;
#pragma unroll
        for (int rg = 0; rg < 16; ++rg) dst[(size_t)crow(rg, hi) * 128] = f2h(acc[rg]);
    }
    __syncthreads();
}

__device__ __forceinline__ void h2_scan(int gtid, int gthreads, h16* __restrict__ UST, const float* __restrict__ DEC) {
    for (int id = gtid; id < 8 * 16384; id += gthreads) {
        const int bh = id >> 14, e = id & 16383, k = e & 127;
        float S = 0.f;
        h16* up = UST + (size_t)bh * 128 * 16384 + e; const float* dp = DEC + (size_t)bh * 128 * 128 + k;
#pragma unroll 8
        for (int c = 0; c < 128; ++c) {
            const float u = h2f(up[(size_t)c * 16384]), d = dp[c * 128];
            up[(size_t)c * 16384] = f2h(S);
            S = fmaf(d, S, u);
        }
    }
}

__device__ __forceinline__ void h3_task(int task, lds_u8* lds, const h16* __restrict__ QH, const h16* __restrict__ LF, const h16* __restrict__ V, const h16* __restrict__ Gt,
                                        const h16* __restrict__ UST, const float* __restrict__ onorm, h16* __restrict__ OM) {
    int tid = threadIdx.x; asm volatile("" : "+v"(tid));
    const int lane = tid & 63, wave = __builtin_amdgcn_readfirstlane(tid >> 6), r = lane & 31, hi = lane >> 5;
    const int bh = task >> 7, c = task & 127, b = bh >> 2, h = bh & 3, k = tid & 127, p = tid >> 7;
    const size_t row0 = (size_t)b * T + c * 64; const int col0 = h * 128;
    float lf[16], g[16], ps[4];
    head(lds, LF, V, row0, col0, tid, lf, g, ps);
    const float R0 = ps[0], G31 = ps[0] + ps[1], R1 = G31 + ps[2], Ri = p < 2 ? R0 : R1;
    __attribute__((address_space(3))) h16* QIN = (__attribute__((address_space(3))) h16*)(lds + OFF_QIN);
    __attribute__((address_space(3))) h16* QD = (__attribute__((address_space(3))) h16*)(lds + OFF_QD);
    __attribute__((address_space(3))) h16* KD = (__attribute__((address_space(3))) h16*)(lds + OFF_KD);
    __attribute__((address_space(3))) h16* QO = (__attribute__((address_space(3))) h16*)(lds + OFF_QO);
    __attribute__((address_space(3))) h16* KO = (__attribute__((address_space(3))) h16*)(lds + OFF_KO);
    __attribute__((address_space(3))) h16* AM = (__attribute__((address_space(3))) h16*)(lds + OFF_A);
    __attribute__((address_space(3))) float* OB = (__attribute__((address_space(3))) float*)(lds + OFF_O);
#pragma unroll
    for (int i = 0; i < 16; ++i) {
        const int t = 16 * p + i;
        const float q = h2f(QH[(row0 + t) * 512 + col0 + k]), kk = 1.f - __expf(lf[i]), gi = g[i];
        QIN[t * LDP + k] = f2h(q * __expf(gi));
        QD[t * LDP + k] = f2bf(q * __expf(fminf(fmaxf(gi - Ri, -80.f), 80.f)));
        KD[t * LDP + k] = f2bf(kk * __expf(fminf(fmaxf(Ri - gi, -80.f), 80.f)));
        if (p >= 2) QO[(t - 32) * LDP + k] = f2h(q * __expf(gi - G31));
        else KO[t * LDP + k] = f2h(kk * __expf(G31 - gi));
    }
    __syncthreads();
    if (wave < 2) {
        const int o0 = 32 * wave;
        f32x16 acc = {};
#pragma unroll
        for (int ks = 0; ks < 8; ++ks) {
            const hx8 af = *(const __attribute__((address_space(3))) hx8*)(QD + (o0 + r) * LDP + ks * 16 + 8 * hi);
            const hx8 bf = *(const __attribute__((address_space(3))) hx8*)(KD + (o0 + r) * LDP + ks * 16 + 8 * hi);
            acc = HG_MFMA_BF16(af, bf, acc);
        }
#pragma unroll
        for (int rg = 0; rg < 16; ++rg) { const int t = crow(rg, hi); AM[(o0 + t) * LDS_S + o0 + r] = (r <= t) ? f2h(acc[rg]) : (h16)0; }
    } else if (wave == 2) {
        f32x16 acc = {};
#pragma unroll
        for (int ks = 0; ks < 8; ++ks) {
            const hx8 af = *(const __attribute__((address_space(3))) hx8*)(QO + r * LDP + ks * 16 + 8 * hi);
            const hx8 bf = *(const __attribute__((address_space(3))) hx8*)(KO + r * LDP + ks * 16 + 8 * hi);
            acc = HG_MFMA_F16(af, bf, acc);
        }
#pragma unroll
        for (int rg = 0; rg < 16; ++rg) AM[(32 + crow(rg, hi)) * LDS_S + r] = f2h(acc[rg]);
    } else if (wave == 3) {
#pragma unroll
        for (int rg = 0; rg < 16; ++rg) AM[crow(rg, hi) * LDS_S + 32 + r] = (h16)0;
    }
    __syncthreads();
    {
        const int ti = wave >> 2, vi = wave & 3;
        const __attribute__((address_space(3))) h16* vT = (const __attribute__((address_space(3))) h16*)(lds + OFF_VT);
        f32x16 acc = {};
        const h16* sp = UST + ((size_t)task * 128 + 32 * vi + r) * 128 + 8 * hi;
#pragma unroll
        for (int ks = 0; ks < 8; ++ks) {
            const hx8 af = *(const __attribute__((address_space(3))) hx8*)(QIN + (32 * ti + r) * LDP + ks * 16 + 8 * hi);
            const hx8 bf = *(const hx8*)(sp + ks * 16);
            acc = HG_MFMA_F16(af, bf, acc);
        }
#pragma unroll
        for (int ks = 0; ks < 4; ++ks) {
            const hx8 af = *(const __attribute__((address_space(3))) hx8*)(AM + (32 * ti + r) * LDS_S + ks * 16 + 8 * hi);
            const hx8 bf = *(const __attribute__((address_space(3))) hx8*)(vT + (32 * vi + r) * LDS_S + ks * 16 + 8 * hi);
            acc = HG_MFMA_F16(af, bf, acc);
        }
#pragma unroll
        for (int rg = 0; rg < 16; ++rg) OB[(32 * ti + crow(rg, hi)) * 132 + 32 * vi + r] = acc[rg];
    }
    __syncthreads();
#pragma unroll
    for (int rr = 0; rr < 8; ++rr) {
        const int row = 8 * wave + rr;
        const float x0 = OB[row * 132 + 2 * lane], x1 = OB[row * 132 + 2 * lane + 1];
        float ss = x0 * x0 + x1 * x1;
#pragma unroll
        for (int o = 1; o < 64; o <<= 1) ss += __shfl_xor(ss, o);
        const float rn = rsqrtf(ss * (1.f / 128.f) + 1e-6f);
        const unsigned gg = *(const unsigned*)(Gt + (row0 + row) * 512 + col0 + 2 * lane);
        const float o0 = x0 * rn * onorm[col0 + 2 * lane] * h2f((h16)(gg & 0xffff)), o1 = x1 * rn * onorm[col0 + 2 * lane + 1] * h2f((h16)(gg >> 16));
        *(unsigned*)(OM + (row0 + row) * 1024 + col0 + 2 * lane) = (unsigned)f2h(o0) | ((unsigned)f2h(o1) << 16);
    }
    __syncthreads();
}
#undef HG_MFMA_F16
#undef HG_MFMA_BF16
}

namespace {
constexpr int B_ = 2, T_ = 8192, D_ = 1024, M_ = B_ * T_;
constexpr int DIN = 4168, DIN_PAD = 4352, DFF = 2816;
constexpr float EPS = 1e-6f;
constexpr int NWAVES = 8, NTHR = 512;

#define GAS __attribute__((address_space(1)))
#define LAS __attribute__((address_space(3)))
typedef unsigned short h16;
typedef float f32x4 __attribute__((ext_vector_type(4)));
typedef unsigned u32x4 __attribute__((ext_vector_type(4)));
typedef unsigned u32x2 __attribute__((ext_vector_type(2)));

__constant__ float c_inv16[16] = {1.f, 0.440366596f, 0.193922743f, 0.0853971019f, 0.0376060307f, 0.0165604409f, 0.00729266461f, 0.00321144611f,
                                  0.00141421356f, 0.000622772437f, 0.000274248188f, 0.000120769735f, 5.31829573e-05f, 2.34199997e-05f, 1.03133852e-05f, 4.54167048e-06f};
__constant__ float c_inv8[8] = {1.f, 0.193922743f, 0.0376060307f, 0.00729266461f, 0.00141421356f, 0.000274248188f, 5.31829573e-05f, 1.03133852e-05f};

constexpr size_t MiB = 1u << 20;
constexpr size_t WS_CTL = 0, CTL_ZERO_BYTES = 1 * MiB;
constexpr size_t WS_MOD = 1 * MiB, WS_LB = 1 * MiB + 64 * 1024;
constexpr size_t WS_WIN = 2 * MiB, WS_WOUT = 11 * MiB, WS_WF1 = 13 * MiB, WS_WF2 = 24 * MiB;
constexpr size_t WS_XN = 30 * MiB;
constexpr size_t WS_GRP = 62 * MiB, GRP_STRIDE = 16 * MiB;
constexpr size_t WS_IK = 190 * MiB, WS_IW = 192 * MiB, WS_IKRAW = 193 * MiB;
constexpr size_t WS_UST = 197 * MiB;
constexpr size_t WS_DEC = 193 * MiB;
constexpr size_t WS_Y = 62 * MiB;
constexpr size_t WS_ACT = 126 * MiB;
constexpr size_t WS_MASK = 229 * MiB;
constexpr size_t WS_END = 245 * MiB;
constexpr int CW_BAR = 4096;

constexpr int RING_BYTES = 135168, LDSCTL_OFF = RING_BYTES, MISC_OFF = LDSCTL_OFF + 320, LDS_BYTES = 139264;

__device__ __forceinline__ float wave_sum(float v) {
#pragma unroll
    for (int o = 1; o < 64; o <<= 1) v += __shfl_xor(v, o);
    return v;
}
__device__ __forceinline__ float wave_max(float v) {
#pragma unroll
    for (int o = 1; o < 64; o <<= 1) v = fmaxf(v, __shfl_xor(v, o));
    return v;
}
__device__ __forceinline__ float sigmoidf_(float v) { return 1.f / (1.f + expf(-v)); }
__device__ __forceinline__ float siluf_(float v) { return v / (1.f + expf(-v)); }
__device__ __forceinline__ unsigned pk_f16(float lo, float hi) {
    typedef _Float16 h2 __attribute__((ext_vector_type(2))); typedef float f2 __attribute__((ext_vector_type(2)));
    const h2 h = __builtin_convertvector((f2){lo, hi}, h2); return __builtin_bit_cast(unsigned, h);
}
__device__ __forceinline__ float h2f(h16 v) { return (float)__builtin_bit_cast(_Float16, v); }
__device__ __forceinline__ h16 f2h(float v) { return __builtin_bit_cast(h16, (_Float16)v); }

__device__ __forceinline__ void sincos_acc(float ang, float& s, float& c) {
    const double a = (double)ang;
    const double n = rint(a * 0.63661977236758134308);
    double y = fma(-n, 1.57079632679489655800, a);
    y = fma(-n, 6.12323399573676603587e-17, y);
    const int q = (int)((long long)n & 3);
    const double y2 = y * y;
    const double sp = y * (1.0 + y2 * (-1.0 / 6.0 + y2 * (1.0 / 120.0 + y2 * (-1.0 / 5040.0 + y2 * (1.0 / 362880.0 + y2 * (-1.0 / 39916800.0 + y2 * (1.0 / 6227020800.0 + y2 * (-1.0 / 1307674368000.0))))))));
    const double cp = 1.0 + y2 * (-0.5 + y2 * (1.0 / 24.0 + y2 * (-1.0 / 720.0 + y2 * (1.0 / 40320.0 + y2 * (-1.0 / 3628800.0 + y2 * (1.0 / 479001600.0 + y2 * (-1.0 / 87178291200.0)))))));
    double sd, cd;
    if (q == 0) { sd = sp; cd = cp; } else if (q == 1) { sd = cp; cd = -sp; } else if (q == 2) { sd = -sp; cd = -cp; } else { sd = -cp; cd = sp; }
    s = (float)sd; c = (float)cd;
}

#define XB_TMO      128
#define XB_XCNT(j)  (256  + 64 * (j))
#define XB_XSUB(j)  (1280 + 64 * (j))
#define XB_XGEN(j)  (2304 + 64 * (j))
#define XB_TOP      3328
#define XB_TOPGEN   3392
#define XCD_BAR_WORDS 3456
#define XB_SPIN_CAP (1u << 22)
__device__ __forceinline__ unsigned xb_ld(unsigned* p)              { return __hip_atomic_load(p, __ATOMIC_RELAXED, __HIP_MEMORY_SCOPE_AGENT); }
__device__ __forceinline__ unsigned xb_add(unsigned* p, unsigned v) { return __hip_atomic_fetch_add(p, v, __ATOMIC_RELAXED, __HIP_MEMORY_SCOPE_AGENT); }
__device__ __forceinline__ unsigned xb_xcc_id() { return (unsigned)__builtin_amdgcn_s_getreg((3 << 11) | 20) & 0xFu; }
#define XB_SPIN(cond, bar) do { unsigned _sp = 0; while (cond) { __builtin_amdgcn_s_sleep(1); \
    if ((++_sp & 255u) == 0u) { if (xb_ld(&(bar)[XB_TMO])) break; if (_sp > XB_SPIN_CAP) { atomicAdd(&(bar)[XB_TMO], 1u); break; } } } } while (0)
struct XcdBarrier { unsigned* bar; unsigned x; volatile LAS unsigned* st; };
__device__ __forceinline__ XcdBarrier xcd_barrier_post(unsigned* bar, volatile LAS unsigned* st) {
    XcdBarrier b; b.bar = bar; b.x = xb_xcc_id(); b.st = st;
    if (threadIdx.x == 0) (void)xb_add(&bar[XB_XCNT(b.x)], 1u);
    return b;
}
__device__ __forceinline__ void xcd_barrier_complete(unsigned* bar, unsigned x, unsigned& nloc, unsigned& nx) {
    const unsigned G = gridDim.x * gridDim.y * gridDim.z;
    unsigned sum, cnt, mine, sp = 0u;
    for (;;) {
        sum = 0u; cnt = 0u; mine = 0u;
#pragma unroll
        for (unsigned j = 0; j < 16; ++j) { const unsigned c = xb_ld(&bar[XB_XCNT(j)]); sum += c; cnt += (c > 0u) ? 1u : 0u; mine = (j == x) ? c : mine; }
        if (sum == G) break;
        __builtin_amdgcn_s_sleep(1);
        if ((++sp & 255u) == 0u) { if (xb_ld(&bar[XB_TMO])) break; if (sp > XB_SPIN_CAP) { atomicAdd(&bar[XB_TMO], 1u); break; } }
    }
    nloc = mine > 0u ? mine : 1u; nx = cnt > 0u ? cnt : 1u;
}
__device__ __forceinline__ void xcd_barrier(const XcdBarrier& b) {
    asm volatile("s_waitcnt vmcnt(0)" ::: "memory");
    __syncthreads();
    if (threadIdx.x == 0) {
        unsigned* bar = b.bar;
        __builtin_amdgcn_s_waitcnt(0);
        unsigned nloc = b.st[0], nx = b.st[1];
        if (nloc == 0u) { xcd_barrier_complete(bar, b.x, nloc, nx); b.st[0] = nloc; b.st[1] = nx; }
        const unsigned old = xb_add(&bar[XB_XSUB(b.x)], 1u);
        const unsigned gen = old / nloc;
        if (old + 1u == (gen + 1u) * nloc) {
            __builtin_amdgcn_fence(__ATOMIC_RELEASE, "agent");
            asm volatile("s_waitcnt vmcnt(0)" ::: "memory");
            const unsigned og = xb_add(&bar[XB_TOP], 1u);
            const unsigned tg = og / nx;
            if (og + 1u == (tg + 1u) * nx) xb_add(&bar[XB_TOPGEN], 1u);
            else XB_SPIN(xb_ld(&bar[XB_TOPGEN]) == tg, bar);
            __builtin_amdgcn_fence(__ATOMIC_ACQUIRE, "agent");
            xb_add(&bar[XB_XGEN(b.x)], 1u);
            asm volatile("s_waitcnt vmcnt(0)" ::: "memory");
        } else {
            XB_SPIN(xb_ld(&bar[XB_XGEN(b.x)]) == gen, bar);
            __builtin_amdgcn_fence(__ATOMIC_ACQUIRE, "agent");
            asm volatile("s_waitcnt vmcnt(0)" ::: "memory");
        }
    }
    __syncthreads();
}

struct EpiIn16 {
    static constexpr bool PERM = true, AFTER_DRAIN = false;
    h16* grp; float* IKRAW; float* IW; const float* lb;
    __device__ __forceinline__ void operator()(const f32x4 (&acc)[2][2][4][2], const pg8::Unit& u, int wr, int wc, int fr, int fq) const {
        const int row0 = u.pm * 256 + wr * 64 + fr;
        if (u.pn < 16) {
            const int g = u.pn >> 1;
            const int jc0 = (u.pn & 1) * 256 + wc * 32 + 8 * fq;
            h16* gb = grp + (size_t)g * ((size_t)M_ * 512);
            float lbv[2][8];
            if (g == 1) {
#pragma unroll
                for (int bj = 0; bj < 2; ++bj)
#pragma unroll
                    for (int e = 0; e < 8; ++e) lbv[bj][e] = lb[jc0 + bj * 128 + e];
            }
#pragma unroll
            for (int ai = 0; ai < 2; ++ai)
#pragma unroll
                for (int m = 0; m < 4; ++m) {
                    h16* rowp = gb + (size_t)(row0 + ai * 128 + m * 16) * 512 + jc0;
#pragma unroll
                    for (int bj = 0; bj < 2; ++bj) {
                        float v[8];
#pragma unroll
                        for (int e = 0; e < 4; ++e) { v[e] = acc[ai][bj][m][0][e]; v[4 + e] = acc[ai][bj][m][1][e]; }
                        if (g == 0) {
#pragma unroll
                            for (int e = 0; e < 8; ++e) v[e] = siluf_(v[e]) * 0.08838834764831845f;
                        } else if (g == 1) {
#pragma unroll
                            for (int e = 0; e < 8; ++e) { const float l = lbv[bj][e]; v[e] = logf(l + (1.f - l) * sigmoidf_(v[e])); }
                        } else if (g == 3) {
#pragma unroll
                            for (int e = 0; e < 8; ++e) v[e] = siluf_(v[e]);
                        } else if (g == 4) {
#pragma unroll
                            for (int e = 0; e < 8; ++e) v[e] *= 0.08838834764831845f;
                        }
                        u32x4 w; w.x = pk_f16(v[0], v[1]); w.y = pk_f16(v[2], v[3]); w.z = pk_f16(v[4], v[5]); w.w = pk_f16(v[6], v[7]);
                        *(u32x4*)(rowp + bj * 128) = w;
                    }
                }
        } else {
#pragma unroll
            for (int ai = 0; ai < 2; ++ai)
#pragma unroll
                for (int m = 0; m < 4; ++m) {
                    const int row = row0 + ai * 128 + m * 16;
                    const f32x4 v0 = acc[ai][0][m][0], v1 = acc[ai][0][m][1];
                    if (wc < 2) { float* p = IKRAW + (size_t)row * 64 + wc * 32 + 8 * fq; *(f32x4*)p = v0; *(f32x4*)(p + 4) = v1; }
                    else if (wc == 2 && fq == 0) { float* p = IW + (size_t)row * 8; *(f32x4*)p = v0 * 0.04419417382415922f; *(f32x4*)(p + 4) = v1 * 0.04419417382415922f; }
                }
        }
    }
};
struct EpiStoreF32 {
    static constexpr bool PERM = false, AFTER_DRAIN = false;
    float* Y; int ldc;
    __device__ __forceinline__ void operator()(const f32x4 (&acc)[2][2][4][2], const pg8::Unit& u, int wr, int wc, int fr, int fq) const {
        const int row0 = u.pm * 256 + wr * 64 + fr, col0 = u.pn * 256 + wc * 32 + 4 * fq;
#pragma unroll
        for (int ai = 0; ai < 2; ++ai)
#pragma unroll
            for (int m = 0; m < 4; ++m) {
                float* rowp = Y + (size_t)(row0 + ai * 128 + m * 16) * ldc + col0;
#pragma unroll
                for (int bj = 0; bj < 2; ++bj)
#pragma unroll
                    for (int n = 0; n < 2; ++n) *(f32x4*)(rowp + bj * 128 + n * 16) = acc[ai][bj][m][n];
            }
    }
};
struct EpiSwiGLU16 {
    static constexpr bool PERM = true, AFTER_DRAIN = false;
    h16* ACT;
    __device__ __forceinline__ void operator()(const f32x4 (&acc)[2][2][4][2], const pg8::Unit& u, int wr, int wc, int fr, int fq) const {
        const int row0 = u.pm * 256 + wr * 64 + fr, hc0 = u.pn * 128 + wc * 32 + 8 * fq;
#pragma unroll
        for (int ai = 0; ai < 2; ++ai)
#pragma unroll
            for (int m = 0; m < 4; ++m) {
                float v[8];
#pragma unroll
                for (int e = 0; e < 4; ++e) { v[e] = siluf_(acc[ai][0][m][0][e]) * acc[ai][1][m][0][e]; v[4 + e] = siluf_(acc[ai][0][m][1][e]) * acc[ai][1][m][1][e]; }
                u32x4 w; w.x = pk_f16(v[0], v[1]); w.y = pk_f16(v[2], v[3]); w.z = pk_f16(v[4], v[5]); w.w = pk_f16(v[6], v[7]);
                *(u32x4*)(ACT + (size_t)(row0 + ai * 128 + m * 16) * DFF + hc0) = w;
            }
    }
};

__device__ __forceinline__ void transpose_item(const float* __restrict__ W, int ldw, int src_col0, int valid, h16* __restrict__ WT, int K, int dst_row0, int k0, LAS float* scr, int lane) {
    const bool ok = (lane & 31) < valid;
#pragma unroll 8
    for (int i = 0; i < 32; ++i) { const int kk = 2 * i + (lane >> 5); scr[kk * 33 + (lane & 31)] = ok ? W[(size_t)(k0 + kk) * ldw + src_col0 + (lane & 31)] : 0.f; }
    asm volatile("s_waitcnt lgkmcnt(0)" ::: "memory");
    const int c = lane & 7;
#pragma unroll
    for (int j = 0; j < 4; ++j) { const int n = (lane >> 3) + 8 * j; const LAS float* s = scr + (8 * c) * 33 + n;
        u32x4 o; o.x = pk_f16(s[0 * 33], s[1 * 33]); o.y = pk_f16(s[2 * 33], s[3 * 33]); o.z = pk_f16(s[4 * 33], s[5 * 33]); o.w = pk_f16(s[6 * 33], s[7 * 33]);
        *(u32x4*)(WT + (size_t)(dst_row0 + n) * K + k0 + 8 * c) = o; }
    asm volatile("s_waitcnt lgkmcnt(0)" ::: "memory");
}

struct Args {
    const float* x; const float* c; const int* positions; const float* w_ada; const float* b_ada;
    const float* n_pre_mix; const float* n_post_mix; const float* n_pre_ffn; const float* n_post_ffn;
    const float* w_in; const float* lbraw; const float* onorm; const float* knw; const float* knb;
    const float* w_out; const float* w_ffn_in; const float* w_ffn_out;
    float* out; unsigned char* ws;
};

__device__ __forceinline__ void normmod_row(const float* __restrict__ xrow, const float* __restrict__ gain, const float* __restrict__ mb, int sc_off, int sh_off, h16* __restrict__ hrow, int lane) {
    const f32x4* xr = (const f32x4*)xrow;
    f32x4 v[4]; float ss = 0.f;
#pragma unroll
    for (int j = 0; j < 4; ++j) { v[j] = xr[lane + 64 * j]; ss += v[j].x * v[j].x + v[j].y * v[j].y + v[j].z * v[j].z + v[j].w * v[j].w; }
    const float r = rsqrtf(wave_sum(ss) * (1.f / D_) + EPS);
#pragma unroll
    for (int j = 0; j < 4; ++j) {
        const int col = (lane + 64 * j) * 4;
        const f32x4 g4 = *(const f32x4*)(gain + col), s4 = *(const f32x4*)(mb + sc_off + col), h4 = *(const f32x4*)(mb + sh_off + col);
        u32x2 w; w.x = pk_f16(v[j].x * r * g4.x * (1.f + s4.x) + h4.x, v[j].y * r * g4.y * (1.f + s4.y) + h4.y);
        w.y = pk_f16(v[j].z * r * g4.z * (1.f + s4.z) + h4.z, v[j].w * r * g4.w * (1.f + s4.w) + h4.w);
        *(u32x2*)(hrow + col) = w;
    }
}

template <bool NEXT>
__device__ __forceinline__ void post_row(const float* xin, const float* __restrict__ Yrow, const float* __restrict__ g_post, const float* __restrict__ mb, int gt_off,
                                         float* xout, const float* __restrict__ g_pre, int sc_off, int sh_off, h16* __restrict__ hrow, int lane) {
    const f32x4* yr = (const f32x4*)Yrow; const f32x4* xr = (const f32x4*)xin; f32x4* xo = (f32x4*)xout;
    f32x4 y[4], xv[4]; float ss = 0.f;
#pragma unroll
    for (int j = 0; j < 4; ++j) { y[j] = yr[lane + 64 * j]; xv[j] = xr[lane + 64 * j]; ss += y[j].x * y[j].x + y[j].y * y[j].y + y[j].z * y[j].z + y[j].w * y[j].w; }
    const float r = rsqrtf(wave_sum(ss) * (1.f / D_) + EPS);
    float s2 = 0.f;
#pragma unroll
    for (int j = 0; j < 4; ++j) {
        const int col = (lane + 64 * j) * 4;
        const f32x4 g4 = *(const f32x4*)(g_post + col), t4 = *(const f32x4*)(mb + gt_off + col);
        xv[j].x += t4.x * (y[j].x * r * g4.x); xv[j].y += t4.y * (y[j].y * r * g4.y); xv[j].z += t4.z * (y[j].z * r * g4.z); xv[j].w += t4.w * (y[j].w * r * g4.w);
        xo[lane + 64 * j] = xv[j];
        s2 += xv[j].x * xv[j].x + xv[j].y * xv[j].y + xv[j].z * xv[j].z + xv[j].w * xv[j].w;
    }
    if (NEXT) {
        const float r2 = rsqrtf(wave_sum(s2) * (1.f / D_) + EPS);
#pragma unroll
        for (int j = 0; j < 4; ++j) {
            const int col = (lane + 64 * j) * 4;
            const f32x4 g4 = *(const f32x4*)(g_pre + col), s4 = *(const f32x4*)(mb + sc_off + col), h4 = *(const f32x4*)(mb + sh_off + col);
            u32x2 w; w.x = pk_f16(xv[j].x * r2 * g4.x * (1.f + s4.x) + h4.x, xv[j].y * r2 * g4.y * (1.f + s4.y) + h4.y);
            w.y = pk_f16(xv[j].z * r2 * g4.z * (1.f + s4.z) + h4.z, xv[j].w * r2 * g4.w * (1.f + s4.w) + h4.w);
            *(u32x2*)(hrow + col) = w;
        }
    }
}

__device__ __forceinline__ void fixup_row(int m, const int* __restrict__ positions, h16* AQ, h16* AK, h16* IQ, const float* __restrict__ IKRAW, h16* __restrict__ IK,
                                          const float* __restrict__ knw, const float* __restrict__ knb, int lane) {
    const float pos = (float)positions[m];
    float s_, c_;
    { const float inv = lane < 16 ? c_inv16[lane] : c_inv8[lane & 7]; sincos_acc(pos * inv, s_, c_); }
    {
        const int h = lane >> 4, i = lane & 15;
        const float cs = __shfl(c_, i), sn = __shfl(s_, i);
        const size_t o = (size_t)m * 512 + h * 128 + i;
        { const float x1 = h2f(AQ[o]), x2 = h2f(AQ[o + 16]); AQ[o] = f2h(x1 * cs - x2 * sn); AQ[o + 16] = f2h(x2 * cs + x1 * sn); }
        { const float x1 = h2f(AK[o]), x2 = h2f(AK[o + 16]); AK[o] = f2h(x1 * cs - x2 * sn); AK[o + 16] = f2h(x2 * cs + x1 * sn); }
    }
    {
        const int h = lane >> 3, i = lane & 7;
        const float cs = __shfl(c_, 16 + i), sn = __shfl(s_, 16 + i);
        const size_t o = (size_t)m * 512 + h * 64 + i;
        const float x1 = h2f(IQ[o]), x2 = h2f(IQ[o + 8]); IQ[o] = f2h(x1 * cs - x2 * sn); IQ[o + 8] = f2h(x2 * cs + x1 * sn);
    }
    {
        const float v = IKRAW[(size_t)m * 64 + lane];
        const float mu = wave_sum(v) * (1.f / 64.f);
        const float d = v - mu;
        const float var = wave_sum(d * d) * (1.f / 64.f);
        float y = d * rsqrtf(var + EPS) * knw[lane] + knb[lane];
        const float other = __shfl_xor(y, 8);
        const float cs = __shfl(c_, 16 + (lane & 7)), sn = __shfl(s_, 16 + (lane & 7));
        if (lane < 8) y = y * cs - other * sn; else if (lane < 16) y = y * cs + other * sn;
        IK[(size_t)m * 64 + lane] = f2h(y);
    }
}

__device__ __forceinline__ void hgrn_naive_task(int task, const h16* __restrict__ QH, const h16* __restrict__ LF, const h16* __restrict__ V, float* __restrict__ OH, int lane) {
    const int bh = task >> 1, b = bh >> 2, h = bh & 3, j = (task & 1) * 64 + lane;
    float S[128];
#pragma unroll
    for (int k = 0; k < 128; ++k) S[k] = 0.f;
    for (int t = 0; t < T_; ++t) {
        const size_t row = (size_t)(b * T_ + t) * 512 + h * 128;
        const float v = h2f(V[row + j]);
        const float f0 = expf(h2f(LF[row + lane])), f1 = expf(h2f(LF[row + 64 + lane]));
        const float q0 = h2f(QH[row + lane]), q1 = h2f(QH[row + 64 + lane]);
        float o = 0.f;
#pragma unroll
        for (int k = 0; k < 64; ++k) {
            const float f = __int_as_float(__builtin_amdgcn_readlane(__float_as_int(f0), k)), q = __int_as_float(__builtin_amdgcn_readlane(__float_as_int(q0), k));
            S[k] = fmaf(f, S[k] - v, v); o = fmaf(q, S[k], o);
        }
#pragma unroll
        for (int k = 0; k < 64; ++k) {
            const float f = __int_as_float(__builtin_amdgcn_readlane(__float_as_int(f1), k)), q = __int_as_float(__builtin_amdgcn_readlane(__float_as_int(q1), k));
            S[64 + k] = fmaf(f, S[64 + k] - v, v); o = fmaf(q, S[64 + k], o);
        }
        OH[row + j] = o;
    }
}

__device__ __forceinline__ unsigned tokey(float f) { const unsigned u = __float_as_uint(f); return (u & 0x80000000u) ? ~u : (u | 0x80000000u); }
#define SCI(s) ((s) + ((s) >> 5))
__device__ __forceinline__ void dsa_query(int m, LAS unsigned char* lds, const h16* __restrict__ IQ, const h16* __restrict__ IK, const float* __restrict__ IW,
                                          unsigned long long* __restrict__ MASK) {
    LAS float* sc = (LAS float*)lds;
    LAS float* qi = (LAS float*)(lds + 33792);
    LAS float* wv = (LAS float*)(lds + 37888);
    LAS unsigned* hist = (LAS unsigned*)(lds + 37920);
    LAS int* sel = (LAS int*)(lds + 38944);
    LAS int* cnt_gt = (LAS int*)(lds + 39968);
    LAS int* cnt_eq = (LAS int*)(lds + 42016);
    LAS unsigned* shp = (LAS unsigned*)(lds + 48160);
    const int b = m / T_, t = m % T_, n = t + 1, tid = threadIdx.x;
    __syncthreads();
    qi[tid] = h2f(IQ[(size_t)m * 512 + tid]);
    if (tid < 8) wv[tid] = IW[(size_t)m * 8 + tid];
    __syncthreads();
    for (int s = tid; s < n; s += NTHR) {
        const u32x4* kr = (const u32x4*)(IK + (size_t)(b * T_ + s) * 64);
        float kf[64];
#pragma unroll
        for (int i = 0; i < 8; ++i) {
            const u32x4 u = kr[i];
            const unsigned w[4] = {u.x, u.y, u.z, u.w};
#pragma unroll
            for (int e = 0; e < 4; ++e) { kf[i * 8 + e * 2] = h2f((h16)(w[e] & 0xffff)); kf[i * 8 + e * 2 + 1] = h2f((h16)(w[e] >> 16)); }
        }
        float score = 0.f;
#pragma unroll
        for (int h = 0; h < 8; ++h) {
            float d = 0.f;
#pragma unroll
            for (int e = 0; e < 64; ++e) d = fmaf(qi[h * 64 + e], kf[e], d);
            score = fmaf(wv[h], fmaxf(d, 0.f), score);
        }
        if (score == 0.f) score = 0.f;
        sc[SCI(s)] = score;
    }
    __syncthreads();
    int nsel;
    if (n <= 256) {
        if (tid < n) sel[tid] = tid;
        nsel = n;
    } else {
        unsigned prefix = 0; int remaining = 256;
        for (int pass = 0; pass < 4; ++pass) {
            const int shift = 24 - 8 * pass;
            if (tid < 256) hist[tid] = 0u;
            __syncthreads();
            for (int i = 0; i < 16; ++i) {
                const int s = tid * 16 + i;
                if (s < n) {
                    const unsigned key = tokey(sc[SCI(s)]);
                    if (pass == 0 || (unsigned)((unsigned long long)key >> (shift + 8)) == prefix) __hip_atomic_fetch_add((unsigned*)(hist + ((key >> shift) & 255u)), 1u, __ATOMIC_RELAXED, __HIP_MEMORY_SCOPE_WORKGROUP);
                }
            }
            __syncthreads();
            if (tid == 0) {
                int cum = 0, bin = 255;
                for (; bin > 0; --bin) { const int c = (int)hist[bin]; if (cum + c >= remaining) break; cum += c; }
                shp[0] = (prefix << 8) | (unsigned)bin; shp[1] = (unsigned)(remaining - cum);
            }
            __syncthreads();
            prefix = shp[0]; remaining = (int)shp[1];
        }
        const unsigned thr = prefix;
        int cg = 0, ce = 0;
        for (int i = 0; i < 16; ++i) { const int s = tid * 16 + i; if (s < n) { const unsigned key = tokey(sc[SCI(s)]); cg += key > thr; ce += key == thr; } }
        cnt_gt[tid] = cg; cnt_eq[tid] = ce;
        __syncthreads();
        if (tid == 0) { int a = 0, e = 0; for (int i = 0; i < NTHR; ++i) { const int g0 = cnt_gt[i], e0 = cnt_eq[i]; cnt_gt[i] = a; cnt_eq[i] = e; a += g0; e += e0; } }
        __syncthreads();
        int pg = cnt_gt[tid], pe = cnt_eq[tid];
        const int ngt = 256 - remaining;
        for (int i = 0; i < 16; ++i) {
            const int s = tid * 16 + i;
            if (s < n) {
                const unsigned key = tokey(sc[SCI(s)]);
                if (key > thr) { if (pg < 256) sel[pg] = s; ++pg; }
                else if (key == thr) { if (pe < remaining) sel[ngt + pe] = s; ++pe; }
            }
        }
        nsel = 256;
    }
    __syncthreads();
    {
        LAS unsigned* mb = (LAS unsigned*)(lds + 44064);
        if (tid < 256) mb[tid] = 0u;
        __syncthreads();
        if (tid < nsel) { const int sidx = sel[tid]; __hip_atomic_fetch_or((unsigned*)(mb + (sidx >> 5)), 1u << (sidx & 31), __ATOMIC_RELAXED, __HIP_MEMORY_SCOPE_WORKGROUP); }
        __syncthreads();
        if (tid < 128) MASK[((size_t)(b * 128 + tid)) * 8192 + t] = (unsigned long long)mb[2 * tid] | ((unsigned long long)mb[2 * tid + 1] << 32);
    }
}

__global__ void __launch_bounds__(NTHR, 2) fwd_kernel(Args a) {
    extern __shared__ __attribute__((aligned(16))) unsigned char lds_raw[];
    LAS unsigned char* lds = (LAS unsigned char*)lds_raw;
    volatile LAS unsigned* MISC = (volatile LAS unsigned*)(lds + MISC_OFF);
    const int tid = threadIdx.x, lane = tid & 63, wave = __builtin_amdgcn_readfirstlane(tid >> 6);
    const int G = gridDim.x, bx = blockIdx.x;
    unsigned char* ws = a.ws;
    unsigned* ctl = (unsigned*)(ws + WS_CTL);
    for (int u = tid; u < (LDS_BYTES - LDSCTL_OFF) / 4; u += NTHR) ((LAS unsigned*)(lds + LDSCTL_OFF))[u] = 0u;
    __syncthreads();
    XcdBarrier bar = xcd_barrier_post(ctl + CW_BAR, MISC + 8);
#define GRID_BAR() xcd_barrier(bar)

    float* MOD = (float*)(ws + WS_MOD); float* LB = (float*)(ws + WS_LB);
    h16* WIN = (h16*)(ws + WS_WIN); h16* WOUT = (h16*)(ws + WS_WOUT); h16* WF1 = (h16*)(ws + WS_WF1); h16* WF2 = (h16*)(ws + WS_WF2);
    h16* XN = (h16*)(ws + WS_XN); h16* OM = XN;
    h16* GRP = (h16*)(ws + WS_GRP);
    h16* QH = GRP; h16* LF = (h16*)(ws + WS_GRP + GRP_STRIDE); h16* V = (h16*)(ws + WS_GRP + 2 * GRP_STRIDE); h16* Gt = (h16*)(ws + WS_GRP + 3 * GRP_STRIDE);
    h16* AQ = (h16*)(ws + WS_GRP + 4 * GRP_STRIDE); h16* AK = (h16*)(ws + WS_GRP + 5 * GRP_STRIDE); h16* AV = (h16*)(ws + WS_GRP + 6 * GRP_STRIDE); h16* IQ = (h16*)(ws + WS_GRP + 7 * GRP_STRIDE);
    h16* IK = (h16*)(ws + WS_IK); float* IW = (float*)(ws + WS_IW); float* IKRAW = (float*)(ws + WS_IKRAW);
    h16* UST = (h16*)(ws + WS_UST); float* DEC = (float*)(ws + WS_DEC); float* Y = (float*)(ws + WS_Y); h16* ACT = (h16*)(ws + WS_ACT);
    unsigned long long* MASK = (unsigned long long*)(ws + WS_MASK);
    const int gw = bx * NWAVES + wave, NGW = G * NWAVES;

    {
        LAS float* scr = (LAS float*)(lds + wave * 16384);
        constexpr int I_IN = (DIN_PAD / 32) * (D_ / 64), I_OUT = (D_ / 32) * (D_ / 64), I_F1 = (2 * DFF / 32) * (D_ / 64), I_F2 = (D_ / 32) * (DFF / 64);
        for (int it = gw; it < I_IN + I_OUT + I_F1 + I_F2; it += NGW) {
            int r = it;
            if (r < I_IN) { const int rb = r / (D_ / 64), kb = r % (D_ / 64); const int valid = DIN - rb * 32; transpose_item(a.w_in, DIN, rb * 32, valid < 0 ? 0 : valid, WIN, D_, rb * 32, kb * 64, scr, lane); continue; } r -= I_IN;
            if (r < I_OUT) { const int rb = r / (D_ / 64), kb = r % (D_ / 64); transpose_item(a.w_out, D_, rb * 32, 32, WOUT, D_, rb * 32, kb * 64, scr, lane); continue; } r -= I_OUT;
            if (r < I_F1) { const int rb = r / (D_ / 64), kb = r % (D_ / 64); const int drow = rb * 32, pn = drow >> 8, bj = (drow >> 7) & 1, i0 = drow & 127;
                transpose_item(a.w_ffn_in, 2 * DFF, bj * DFF + pn * 128 + i0, 32, WF1, D_, drow, kb * 64, scr, lane); continue; } r -= I_F1;
            { const int rb = r / (DFF / 64), kb = r % (DFF / 64); transpose_item(a.w_ffn_out, D_, rb * 32, 32, WF2, DFF, rb * 32, kb * 64, scr, lane); }
        }
        __syncthreads();
        LAS float* scs = (LAS float*)lds;
        LAS float* part = (LAS float*)(lds + 8192);
        for (int i = tid; i < 2048; i += NTHR) scs[i] = siluf_(a.c[i]);
        __syncthreads();
        for (int cb = bx; cb < 256; cb += G) {
            const int rl = tid / 6, q = tid % 6;
            if (rl < 85) {
                f32x4 a0 = {0.f, 0.f, 0.f, 0.f}, a1 = {0.f, 0.f, 0.f, 0.f};
                for (int d = rl; d < 1024; d += 85) { const f32x4 w4 = *(const f32x4*)(a.w_ada + (size_t)d * 6144 + 24 * cb + 4 * q); a0 += w4 * scs[d]; a1 += w4 * scs[1024 + d]; }
#pragma unroll
                for (int e = 0; e < 4; ++e) { part[(rl * 2 + 0) * 24 + 4 * q + e] = a0[e]; part[(rl * 2 + 1) * 24 + 4 * q + e] = a1[e]; }
            }
            __syncthreads();
            if (tid < 48) { const int bb = tid / 24, col = tid % 24; float s = 0.f; for (int r2 = 0; r2 < 85; ++r2) s += part[(r2 * 2 + bb) * 24 + col]; MOD[bb * 6144 + 24 * cb + col] = s + a.b_ada[24 * cb + col]; }
            __syncthreads();
        }
        if (bx == 0) for (int i = tid; i < 512; i += NTHR) LB[i] = 1.f / (1.f + expf(a.lbraw[512 + i] - a.lbraw[i]));
        { u32x4* mz = (u32x4*)MASK; const u32x4 z = {0u, 0u, 0u, 0u}; for (size_t i2 = (size_t)bx * NTHR + tid; i2 < (size_t)(16 * MiB / 16); i2 += (size_t)G * NTHR) mz[i2] = z; }
    }
    GRID_BAR();
    for (int m = gw; m < M_; m += NGW) normmod_row(a.x + (size_t)m * D_, a.n_pre_mix, MOD + (m / T_) * 6144, 1024, 0, XN + (size_t)m * D_, lane);
    GRID_BAR();
    {
        pg8::Gemm g{XN, WIN, M_, DIN_PAD, D_}; pg8::StaticOrder S; S.init(M_, DIN_PAD, G, bx);
        EpiIn16 E{GRP, IKRAW, IW, LB};
        pg8::gemm_phase<EpiIn16, pg8::StaticOrder, true, true>(lds, g, S, E);
    }
    GRID_BAR();
    for (int m = gw; m < M_; m += NGW) fixup_row(m, a.positions, AQ, AK, IQ, IKRAW, IK, a.knw, a.knb, lane);
    GRID_BAR();
    for (int task = bx; task < 1024; task += G) hg::h1_task(task, lds, LF, V, UST, DEC);
    for (int task = gw; task < 2048; task += NGW) idx::select_task(task, lds + wave * idx::WAVE_LDS, IQ, IK, IW, (unsigned*)MASK, lane);
    GRID_BAR();
    hg::h2_scan(bx * NTHR + tid, G * NTHR, UST, DEC);
    for (int u = bx; u < 256; u += G) {
        const int bh = u & 7, qb = 31 - (u >> 3), b = bh >> 2, h = bh & 3;
        att::BlockRef cur;
        cur.Q = AQ + ((size_t)(b * T_ + qb * 256)) * 512 + h * 128; cur.K = AK + (size_t)b * T_ * 512 + h * 128; cur.V = AV + (size_t)b * T_ * 512 + h * 128;
        cur.O = OM + ((size_t)(b * T_ + qb * 256)) * 1024 + 512 + h * 128; cur.MK = MASK + (size_t)b * 128 * 8192 + qb * 256; cur.P0 = qb * 256;
        att::Seam S;
        att::prime(cur, (char*)lds_raw, S);
        att::block(cur, cur, (char*)lds_raw, S);
    }
    GRID_BAR();
    for (int task = bx; task < 1024; task += G) hg::h3_task(task, lds, QH, LF, V, Gt, UST, a.onorm, OM);
    GRID_BAR();
    {
        pg8::Gemm g{OM, WOUT, M_, D_, D_}; pg8::StaticOrder S; S.init(M_, D_, G, bx);
        EpiStoreF32 E{Y, D_};
        pg8::gemm_phase<EpiStoreF32, pg8::StaticOrder, true, true>(lds, g, S, E);
    }
    GRID_BAR();
    for (int m = gw; m < M_; m += NGW)
        post_row<true>(a.x + (size_t)m * D_, Y + (size_t)m * D_, a.n_post_mix, MOD + (m / T_) * 6144, 2048, a.out + (size_t)m * D_, a.n_pre_ffn, 4096, 3072, XN + (size_t)m * D_, lane);
    GRID_BAR();
    {
        pg8::Gemm g{XN, WF1, M_, 2 * DFF, D_}; pg8::StaticOrder S; S.init(M_, 2 * DFF, G, bx);
        EpiSwiGLU16 E{ACT};
        pg8::gemm_phase<EpiSwiGLU16, pg8::StaticOrder, true, true>(lds, g, S, E);
    }
    GRID_BAR();
    {
        pg8::Gemm g{ACT, WF2, M_, D_, DFF}; pg8::StaticOrder S; S.init(M_, D_, G, bx);
        EpiStoreF32 E{Y, D_};
        pg8::gemm_phase<EpiStoreF32, pg8::StaticOrder, true, true>(lds, g, S, E);
    }
    GRID_BAR();
    for (int m = gw; m < M_; m += NGW)
        post_row<false>(a.out + (size_t)m * D_, Y + (size_t)m * D_, a.n_post_ffn, MOD + (m / T_) * 6144, 5120, a.out + (size_t)m * D_, nullptr, 0, 0, nullptr, lane);
}
}

extern "C" void kernel_launch(void* const* d_in, const int* in_sizes, int n_in, void* d_out, int out_size, void* d_ws, size_t ws_size, hipStream_t stream) {
    static int grid = 0;
    if (grid == 0) {
        if (n_in != 17 || in_sizes[0] != M_ * D_ || out_size != M_ * D_ || ws_size < WS_END) { fprintf(stderr, "kernel_launch: unexpected problem (n_in %d, ws %zu); nothing launched\n", n_in, ws_size); grid = -1; return; }
        int dev = 0, cus = 0, per_cu = 0;
        if (hipGetDevice(&dev) != hipSuccess || hipDeviceGetAttribute(&cus, hipDeviceAttributeMultiprocessorCount, dev) != hipSuccess) { grid = -1; return; }
        if (hipFuncSetAttribute((const void*)fwd_kernel, hipFuncAttributeMaxDynamicSharedMemorySize, LDS_BYTES) != hipSuccess) { fprintf(stderr, "kernel_launch: hipFuncSetAttribute failed\n"); grid = -1; return; }
        if (hipOccupancyMaxActiveBlocksPerMultiprocessor(&per_cu, (const void*)fwd_kernel, NTHR, LDS_BYTES) != hipSuccess || per_cu < 1) fprintf(stderr, "kernel_launch: occupancy query reports %d\n", per_cu);
        (void)hipGetLastError();
        grid = cus;
        if (grid != 256) fprintf(stderr, "kernel_launch: %d CUs (expected 256)\n", grid);
    }
    if (grid < 0) return;
    if (hipMemsetAsync((char*)d_ws + WS_CTL, 0, CTL_ZERO_BYTES, stream) != hipSuccess) return;
    Args a{};
    a.x = (const float*)d_in[0]; a.c = (const float*)d_in[1]; a.positions = (const int*)d_in[2]; a.w_ada = (const float*)d_in[3]; a.b_ada = (const float*)d_in[4];
    a.n_pre_mix = (const float*)d_in[5]; a.n_post_mix = (const float*)d_in[6]; a.n_pre_ffn = (const float*)d_in[7]; a.n_post_ffn = (const float*)d_in[8];
    a.w_in = (const float*)d_in[9]; a.lbraw = (const float*)d_in[10]; a.onorm = (const float*)d_in[11]; a.knw = (const float*)d_in[12]; a.knb = (const float*)d_in[13];
    a.w_out = (const float*)d_in[14]; a.w_ffn_in = (const float*)d_in[15]; a.w_ffn_out = (const float*)d_in[16];
    a.out = (float*)d_out; a.ws = (unsigned char*)d_ws;
    hipLaunchKernelGGL(fwd_kernel, dim3(grid), dim3(NTHR), LDS_BYTES, stream, a);
}
```

```cpp
#include <hip/hip_runtime.h>
#include <hip/hip_fp16.h>
#include <cstdio>
#include <cstdint>

namespace pg8 {
#define PG8_LAS __attribute__((address_space(3)))
typedef unsigned short h16_t;
typedef short bf16x8 __attribute__((ext_vector_type(8)));
typedef _Float16 half8 __attribute__((ext_vector_type(8)));
typedef float f32x4 __attribute__((ext_vector_type(4)));
typedef unsigned u32x4 __attribute__((ext_vector_type(4)));
constexpr int BM = 256, BK = 64, HALF = 128, HTB = HALF * BK * 2, STAGE_BYTES = 8 * HTB, NXCD = 8, WGM = 8;

__host__ __device__ __forceinline__ int lds_byte(int r, int c) { const int st = (r >> 4) * 2 + (c >> 5), rr = r & 15, cc = c & 31, ob = rr * 64 + cc * 2; return st * 1024 + (ob ^ (((ob >> 9) & 1) << 5)); }
__host__ __device__ __forceinline__ void stage_rc(int b, int& R, int& C) { const int st = b / 1024, sb = b % 1024, swz = sb ^ (((sb >> 9) & 1) << 5); R = (st >> 1) * 16 + swz / 64; C = (st & 1) * 32 + (swz % 64) / 2; }
__host__ __device__ __forceinline__ int perm32(int rho) { const int n = rho >> 4, i = rho & 15; return 8 * (i >> 2) + 4 * n + (i & 3); }

struct Unit { int pm, pn; };
struct Gemm { const h16_t* A; const h16_t* Bt; int M, N, K; };

struct StaticOrder {
    int nM, nN, nwg, G, c;
    __host__ __device__ void init(int M, int N, int G_, int c_) { nM = M / BM; nN = N / BM; nwg = nM * nN; G = G_; c = c_; }
    __host__ __device__ bool next(int i, Unit& u) const {
        const long L = (long)i * G + c; if (L >= nwg) return false;
        int wgid = (int)L; { const int q = nwg / NXCD, r = nwg % NXCD, xcd = wgid % NXCD, off = wgid / NXCD; wgid = (xcd < r ? xcd * (q + 1) : r * (q + 1) + (xcd - r) * q) + off; }
        const int nig = WGM * nN, gid = wgid / nig, fm = gid * WGM, gsz = (nM - fm) < WGM ? (nM - fm) : WGM;
        u.pm = fm + ((wgid % nig) % gsz); u.pn = (wgid % nig) / gsz; return true;
    }
    __device__ __forceinline__ void a_ready(const Unit&) const {}
    __device__ __forceinline__ void done(const Unit&) const {}
};

template <class Epi, class Sched, bool ALIGN_EPI = false, bool SP2 = false>
__device__ __forceinline__ void gemm_phase(PG8_LAS unsigned char* lds, const Gemm g, const Sched& S, const Epi& E) {
    int tid = threadIdx.x; asm volatile("" : "+v"(tid));
    const int wid = __builtin_amdgcn_readfirstlane(tid >> 6), lane = tid & 63, wr = wid >> 2, wc = wid & 3, fr = lane & 15, fq = lane >> 4;
    const int K = g.K, nt = K / BK;
    unsigned voffA[2], voffB[2];
#pragma unroll
    for (int i = 0; i < 2; ++i) { int R, C; stage_rc(tid * 16 + i * 8192, R, C); const int Rb = Epi::PERM ? ((R & ~31) + perm32(R & 31)) : R;
        voffA[i] = (unsigned)(R * K + C) * 2u; voffB[i] = (unsigned)(Rb * K + C) * 2u; }
    const size_t kstep = (size_t)(BK * 2);
    const size_t hstep = (size_t)HALF * K * 2;
    const size_t tstep = 2 * hstep;
    const unsigned ldsw = (unsigned)wid * 1024u;
    const int aoff = lds_byte(wr * 64 + fr, fq * 8), boff = lds_byte(wc * 32 + fr, fq * 8);
#define PG8_SA(b, h) (((b) * 2 + (h)) * HTB)
#define PG8_SB(b, h) ((4 + (b) * 2 + (h)) * HTB)
#define PG8_STAGE(bufoff, gbase, voff) do { _Pragma("unroll") for (int _i = 0; _i < 2; ++_i) \
        __builtin_amdgcn_global_load_lds((const unsigned*)((const char*)(gbase) + (voff)[_i]), (PG8_LAS unsigned*)(lds + (bufoff) + ldsw + _i * 8192), 16, 0, 0); } while (0)
#define PG8_LDA(dst, b, h) do { _Pragma("unroll") for (int m = 0; m < 4; ++m) _Pragma("unroll") for (int k = 0; k < 2; ++k) dst[m][k] = *(const PG8_LAS bf16x8*)(lds + PG8_SA(b, h) + aoff + m * 2048 + k * 1024); } while (0)
#define PG8_LDB(dst, b, h) do { _Pragma("unroll") for (int n = 0; n < 2; ++n) _Pragma("unroll") for (int k = 0; k < 2; ++k) dst[n][k] = *(const PG8_LAS bf16x8*)(lds + PG8_SB(b, h) + boff + n * 2048 + k * 1024); } while (0)
#define PG8_MMA(ai, bj, At, Bt) do { __builtin_amdgcn_s_setprio(1); _Pragma("unroll") for (int m = 0; m < 4; ++m) _Pragma("unroll") for (int n = 0; n < 2; ++n) _Pragma("unroll") for (int k = 0; k < 2; ++k) \
        acc[ai][bj][m][n] = __builtin_amdgcn_mfma_f32_16x16x32_f16(__builtin_bit_cast(half8, Bt[n][k]), __builtin_bit_cast(half8, At[m][k]), acc[ai][bj][m][n], 0, 0, 0); __builtin_amdgcn_s_setprio(0); } while (0)
#define PG8_WAIT_V(n) asm volatile("s_waitcnt vmcnt(" #n ")" ::: "memory")
#define PG8_WAIT_L(n) asm volatile("s_waitcnt lgkmcnt(" #n ")" ::: "memory")
#define PG8_BAR __builtin_amdgcn_s_barrier()
#define PG8_SCHED __builtin_amdgcn_sched_barrier(0)
    Unit cur, nxt; int ui = 0;
    if (!S.next(0, cur)) return;
    f32x4 acc[2][2][4][2];
#pragma unroll
    for (int a = 0; a < 2; ++a)
#pragma unroll
        for (int b = 0; b < 2; ++b)
#pragma unroll
            for (int m = 0; m < 4; ++m)
#pragma unroll
                for (int n = 0; n < 2; ++n) acc[a][b][m][n] = (f32x4){0.f, 0.f, 0.f, 0.f};
    bf16x8 At[4][2], B0[2][2], B1[2][2];
    const char* cA = (const char*)g.A + (size_t)cur.pm * tstep; const char* cB = (const char*)g.Bt + (size_t)cur.pn * tstep;
    S.a_ready(cur);
    if constexpr (SP2) {
        PG8_STAGE(PG8_SB(0, 0), cB, voffB); PG8_STAGE(PG8_SB(0, 1), cB + hstep, voffB); PG8_STAGE(PG8_SA(0, 0), cA, voffA); PG8_STAGE(PG8_SA(0, 1), cA + hstep, voffA);
        if (wr == 1) PG8_BAR;
        PG8_WAIT_V(2); PG8_BAR;
        PG8_STAGE(PG8_SB(1, 0), cB + kstep, voffB); PG8_STAGE(PG8_SA(1, 0), cA + kstep, voffA); PG8_STAGE(PG8_SB(1, 1), cB + hstep + kstep, voffB);
        PG8_WAIT_V(6); PG8_BAR;
    } else {
        PG8_STAGE(PG8_SB(0, 0), cB, voffB); PG8_STAGE(PG8_SA(0, 0), cA, voffA); PG8_STAGE(PG8_SB(0, 1), cB + hstep, voffB); PG8_STAGE(PG8_SA(0, 1), cA + hstep, voffA);
        if (wr == 1) PG8_BAR;
        PG8_WAIT_V(4); PG8_BAR;
        PG8_STAGE(PG8_SB(1, 0), cB + kstep, voffB); PG8_STAGE(PG8_SA(1, 0), cA + kstep, voffA); PG8_STAGE(PG8_SB(1, 1), cB + hstep + kstep, voffB);
        PG8_WAIT_V(6); PG8_BAR;
    }
    for (;;) {
        const bool has_next = S.next(ui + 1, nxt);
        const char* nA = has_next ? (const char*)g.A + (size_t)nxt.pm * tstep : cA; const char* nB = has_next ? (const char*)g.Bt + (size_t)nxt.pn * tstep : cB;
        for (int t = 0; t < nt; t += 2) {
            const bool last = (t == nt - 2);
            const char* a1 = cA + (size_t)(t + 1) * kstep;
            const char* a2 = last ? nA : cA + (size_t)(t + 2) * kstep; const char* b2 = last ? nB : cB + (size_t)(t + 2) * kstep;
            const char* a3 = a2 + kstep; const char* b3 = b2 + kstep;
            if (last && has_next) S.a_ready(nxt);
            if constexpr (SP2) {
            PG8_LDB(B0, 0, 0); PG8_LDB(B1, 0, 1); PG8_SCHED; PG8_LDA(At, 0, 0); PG8_STAGE(PG8_SA(1, 1), a1 + hstep, voffA);
            PG8_WAIT_V(8); PG8_WAIT_L(0); PG8_BAR; PG8_MMA(0, 0, At, B0); PG8_MMA(0, 1, At, B1); PG8_BAR; PG8_SCHED;
            PG8_LDA(At, 0, 1); PG8_STAGE(PG8_SB(0, 0), b2, voffB); PG8_STAGE(PG8_SB(0, 1), b2 + hstep, voffB); PG8_STAGE(PG8_SA(0, 0), a2, voffA);
            PG8_WAIT_V(8); PG8_WAIT_L(0); PG8_BAR; PG8_MMA(1, 0, At, B0); PG8_MMA(1, 1, At, B1); PG8_BAR; PG8_SCHED;
            PG8_LDB(B0, 1, 0); PG8_LDB(B1, 1, 1); PG8_SCHED; PG8_LDA(At, 1, 0); PG8_STAGE(PG8_SA(0, 1), a2 + hstep, voffA);
            PG8_WAIT_V(8); PG8_WAIT_L(0); PG8_BAR; PG8_MMA(0, 0, At, B0); PG8_MMA(0, 1, At, B1); PG8_BAR; PG8_SCHED;
            PG8_LDA(At, 1, 1); PG8_STAGE(PG8_SB(1, 0), b3, voffB); PG8_STAGE(PG8_SB(1, 1), b3 + hstep, voffB); PG8_STAGE(PG8_SA(1, 0), a3, voffA);
            PG8_WAIT_V(8); PG8_WAIT_L(0); PG8_BAR; PG8_MMA(1, 0, At, B0); PG8_MMA(1, 1, At, B1); PG8_BAR; PG8_SCHED;
            } else {
            PG8_LDB(B0, 0, 0); PG8_SCHED; PG8_LDA(At, 0, 0); PG8_STAGE(PG8_SA(1, 1), a1 + hstep, voffA);
            PG8_WAIT_L(8); PG8_BAR; PG8_WAIT_L(0); PG8_MMA(0, 0, At, B0); PG8_BAR; PG8_SCHED;
            PG8_LDB(B1, 0, 1); PG8_STAGE(PG8_SB(0, 0), b2, voffB);
            PG8_BAR; PG8_WAIT_L(0); PG8_MMA(0, 1, At, B1); PG8_BAR;
            PG8_LDA(At, 0, 1); PG8_STAGE(PG8_SA(0, 0), a2, voffA);
            PG8_BAR; PG8_WAIT_L(0); PG8_MMA(1, 0, At, B0); PG8_BAR; PG8_SCHED;
            PG8_STAGE(PG8_SB(0, 1), b2 + hstep, voffB);
            PG8_WAIT_V(6); PG8_BAR; PG8_MMA(1, 1, At, B1); PG8_BAR;
            PG8_LDB(B0, 1, 0); PG8_SCHED; PG8_LDA(At, 1, 0); PG8_STAGE(PG8_SA(0, 1), a2 + hstep, voffA);
            PG8_WAIT_L(8); PG8_BAR; PG8_WAIT_L(0); PG8_MMA(0, 0, At, B0); PG8_BAR; PG8_SCHED;
            PG8_LDB(B1, 1, 1); PG8_STAGE(PG8_SB(1, 0), b3, voffB);
            PG8_BAR; PG8_WAIT_L(0); PG8_MMA(0, 1, At, B1); PG8_BAR;
            PG8_LDA(At, 1, 1); PG8_STAGE(PG8_SA(1, 0), a3, voffA);
            PG8_BAR; PG8_WAIT_L(0); PG8_MMA(1, 0, At, B0); PG8_BAR; PG8_SCHED;
            PG8_STAGE(PG8_SB(1, 1), b3 + hstep, voffB);
            PG8_WAIT_V(6); PG8_BAR; PG8_MMA(1, 1, At, B1); PG8_BAR;
            }
        }
        if constexpr (ALIGN_EPI) { if (wr == 0) PG8_BAR; }
        if constexpr (!Epi::AFTER_DRAIN) { E(acc, cur, wr, wc, fr, fq); S.done(cur); }
        if (!has_next) break;
#pragma unroll
        for (int a = 0; a < 2; ++a)
#pragma unroll
            for (int b = 0; b < 2; ++b)
#pragma unroll
                for (int m = 0; m < 4; ++m)
#pragma unroll
                    for (int n = 0; n < 2; ++n) acc[a][b][m][n] = (f32x4){0.f, 0.f, 0.f, 0.f};
        cur = nxt; cA = nA; cB = nB; ++ui;
        if constexpr (ALIGN_EPI) { if (wr == 1) PG8_BAR; }
    }
    PG8_WAIT_V(0);
    if constexpr (!ALIGN_EPI) { if (wr == 0) PG8_BAR; }
    PG8_BAR;
#undef PG8_SA
#undef PG8_SB
#undef PG8_STAGE
#undef PG8_LDA
#undef PG8_LDB
#undef PG8_MMA
#undef PG8_WAIT_V
#undef PG8_WAIT_L
#undef PG8_BAR
#undef PG8_SCHED
}
}

namespace att {
constexpr int D = 128, LDQ = 512;
constexpr int NW = 8, QBLK = 32, KVBLK = 64, QB = NW * QBLK;
constexpr int SHM_V = KVBLK * D * 2, SHM_K = KVBLK * D * 2;
constexpr int LDS_ATT = 2 * SHM_V + 2 * SHM_K + NW * 64 * 4;
constexpr float THR = 8.f;
typedef unsigned short h16;
typedef short hx8 __attribute__((ext_vector_type(8)));
typedef _Float16 half8 __attribute__((ext_vector_type(8)));
typedef short s16x4 __attribute__((ext_vector_type(4)));
typedef float f32x16 __attribute__((ext_vector_type(16)));
typedef float f32x4 __attribute__((ext_vector_type(4)));
typedef unsigned u32x4 __attribute__((ext_vector_type(4)));
typedef unsigned long long u64;
#define KSWZ(row, colB) ((row) * 256 + ((colB) ^ (((row) & 7) << 4)))
#define SBAR() __builtin_amdgcn_sched_barrier(0)
#define MFMA32(a, b, c) __builtin_amdgcn_mfma_f32_32x32x16_f16(__builtin_bit_cast(half8, a), __builtin_bit_cast(half8, b), c, 0, 0, 0)
__device__ __forceinline__ int v_st(int k, int c) { const int kk = (k & ~0xC) | ((k & 4) << 1) | ((k & 8) >> 1); return ((kk >> 3) * 4 + (c >> 5)) * 512 + ((kk & 7) * 32 + (c & 31)) * 2; }
__device__ __forceinline__ int v_rd_base(int lane) { return ((lane & 3) << 3) | (((lane >> 2) & 3) << 6) | (((lane >> 4) & 1) << 5) | (((lane >> 5) & 1) << 8); }
constexpr int v_rd_off(int d0, int ks, int half) { return d0 * 512 + ks * 4096 + half * 2048; }
__device__ __forceinline__ int crow(int r, int hi) { return (r & 3) + 8 * (r >> 2) + 4 * hi; }
__device__ __forceinline__ unsigned cvtpk(float lo, float hi) {
    typedef _Float16 h2 __attribute__((ext_vector_type(2))); typedef float f2 __attribute__((ext_vector_type(2)));
    const h2 h = __builtin_convertvector((f2){lo, hi}, h2); return __builtin_bit_cast(unsigned, h);
}
__device__ __forceinline__ hx8 load8(const h16* p) { return *reinterpret_cast<const hx8*>(p); }
__device__ __forceinline__ void mask_bits(f32x16& p0, f32x16& p1, u64 mw, int hi) {
    const float NEG = -__builtin_inff();
    const unsigned lo = (unsigned)mw >> (4 * hi), hh = (unsigned)(mw >> 32) >> (4 * hi);
#pragma unroll
    for (int r = 0; r < 16; ++r) {
        const int c = (r & 3) + 8 * (r >> 2);
        if (!((lo >> c) & 1u)) p0[r] = NEG;
        if (!((hh >> c) & 1u)) p1[r] = NEG;
    }
}
__device__ __forceinline__ void partialSM(f32x16& p0, f32x16& p1, float& m_reg, float& mn, float& alpha) {
    float pmax = p0[0]; for (int r = 1; r < 16; ++r) pmax = fmaxf(pmax, p0[r]); for (int r = 0; r < 16; ++r) pmax = fmaxf(pmax, p1[r]);
    { auto rr = __builtin_amdgcn_permlane32_swap(__float_as_uint(pmax), __float_as_uint(pmax), false, false);
      pmax = fmaxf(__uint_as_float(rr[0]), __uint_as_float(rr[1])); }
    constexpr float C2 = 1.4426950408889634f;
    if (__builtin_expect(__all((pmax - m_reg) <= THR), 1)) { mn = m_reg; alpha = 1.f; }
    else { mn = fmaxf(m_reg, pmax); alpha = __builtin_amdgcn_exp2f((m_reg - mn) * C2); m_reg = mn; }
    const float mnL = -mn * C2;
    for (int r = 0; r < 16; ++r) p0[r] = fmaf(p0[r], C2, mnL); for (int r = 0; r < 16; ++r) p1[r] = fmaf(p1[r], C2, mnL);
    for (int r = 0; r < 16; ++r) p0[r] = __builtin_amdgcn_exp2f(p0[r]);
}
__device__ __forceinline__ void finishSM(f32x16& p0, f32x16& p1, float alpha, float& l_reg, hx8& pa0, hx8& pa1, hx8& pa2, hx8& pa3) {
    for (int r = 0; r < 16; ++r) p1[r] = __builtin_amdgcn_exp2f(p1[r]);
    float ps = 0; for (int r = 0; r < 16; ++r) ps += p0[r]; for (int r = 0; r < 16; ++r) ps += p1[r];
    { auto rr = __builtin_amdgcn_permlane32_swap(__float_as_uint(ps), __float_as_uint(ps), false, false);
      ps = __uint_as_float(rr[0]) + __uint_as_float(rr[1]); }
    l_reg = l_reg * alpha + ps;
#define PK4(P, B_, OUT) do { unsigned a0 = cvtpk(P[B_+0], P[B_+1]), a1 = cvtpk(P[B_+2], P[B_+3]);                          \
        unsigned b0 = cvtpk(P[B_+4], P[B_+5]), b1 = cvtpk(P[B_+6], P[B_+7]);                                             \
        auto r0 = __builtin_amdgcn_permlane32_swap(a0, b0, false, false); auto r1 = __builtin_amdgcn_permlane32_swap(a1, b1, false, false); \
        u32x4 w = {r0[0], r1[0], r0[1], r1[1]}; OUT = *reinterpret_cast<hx8*>(&w); } while (0)
    PK4(p0, 0, pa0); PK4(p0, 8, pa1); PK4(p1, 0, pa2); PK4(p1, 8, pa3);
#undef PK4
}
template <int KB>
__device__ __forceinline__ void qkt(f32x16& p0, f32x16& p1, const char* K_lds, int r32, int hi, const hx8* qr) {
    p0 = f32x16{}; p1 = f32x16{};
    const char* kb[4];
#pragma unroll
    for (int dd = 0; dd < 4; ++dd) kb[dd] = K_lds + KB * SHM_K + KSWZ(r32, (dd * 16 + hi * 8) * 2);
#pragma unroll
    for (int d0 = 0; d0 < 8; ++d0) { const char* a = kb[d0 & 3] + (d0 >> 2) * 128;
        hx8 b0 = *reinterpret_cast<const hx8*>(a);
        hx8 b1 = *reinterpret_cast<const hx8*>(a + 32 * 256);
        p0 = MFMA32(b0, qr[d0], p0);
        p1 = MFMA32(b1, qr[d0], p1); }
}
template <int VB>
__device__ __forceinline__ void pv_tile(f32x16* o, int vb0, hx8 pa0, hx8 pa1, hx8 pa2, hx8 pa3) {
#define TRRD(dst, off) asm volatile("ds_read_b64_tr_b16 %0, %1 offset:%2" : "=&v"(dst) : "v"(vb0), "i"(off) : "memory")
#define PV_D0(d0) do { s16x4 l0, l1, l2, l3, h0, h1, h2, h3; constexpr int b_ = VB * SHM_V + v_rd_off(d0, 0, 0); \
        TRRD(l0, b_); TRRD(h0, b_ + 2048); TRRD(l1, b_ + 4096); TRRD(h1, b_ + 6144); TRRD(l2, b_ + 8192); TRRD(h2, b_ + 10240); TRRD(l3, b_ + 12288); TRRD(h3, b_ + 14336); \
        asm volatile("s_waitcnt lgkmcnt(0)" ::: "memory"); SBAR();   \
        o[d0] = MFMA32(pa0, ((hx8){l0[0], l0[1], l0[2], l0[3], h0[0], h0[1], h0[2], h0[3]}), o[d0]);   \
        o[d0] = MFMA32(pa1, ((hx8){l1[0], l1[1], l1[2], l1[3], h1[0], h1[1], h1[2], h1[3]}), o[d0]);   \
        o[d0] = MFMA32(pa2, ((hx8){l2[0], l2[1], l2[2], l2[3], h2[0], h2[1], h2[2], h2[3]}), o[d0]);   \
        o[d0] = MFMA32(pa3, ((hx8){l3[0], l3[1], l3[2], l3[3], h3[0], h3[1], h3[2], h3[3]}), o[d0]); } while (0)
    PV_D0(0); PV_D0(1); PV_D0(2); PV_D0(3);
#undef PV_D0
#undef TRRD
}
struct BlockRef { const h16* Q; const h16* K; const h16* V; h16* O; const u64* MK; float* ML; int P0, jlo, nt, ldo; };
struct Seam { hx8 qr[8]; hx8 st_v0, st_v1, st_k0, st_k1; };
#define ROW(p, k0, rr) ((p) + (size_t)((k0) + (rr)) * LDQ + sc)
#define VMW() asm volatile("s_waitcnt vmcnt(0)" ::: "memory")
#define VMWN(n) asm volatile("s_waitcnt vmcnt(%0)" :: "i"(n) : "memory")
#define SLOAD_H(Kp, Vp, k0) do { S.st_v0 = load8(ROW(Vp, k0, sr)); S.st_v1 = load8(ROW(Vp, k0, 32 + sr));              \
                         S.st_k0 = load8(ROW(Kp, k0, sr)); S.st_k1 = load8(ROW(Kp, k0, 32 + sr)); } while (0)
#define SWRITE_HK(bf) do { *(hx8*)(K_lds + (bf) * SHM_K + kws) = S.st_k0; *(hx8*)(K_lds + (bf) * SHM_K + kws + 32 * 256) = S.st_k1; } while (0)
#define SWRITE_HV(bf) do { *(hx8*)(V_lds + (bf) * SHM_V + vst0) = S.st_v0; *(hx8*)(V_lds + (bf) * SHM_V + vst1) = S.st_v1; } while (0)
#define SWRITE_H(bf) do { SWRITE_HV(bf); SWRITE_HK(bf); } while (0)
__device__ __forceinline__ void prime(const BlockRef& cur, char* lds, Seam& S) {
    const int tid = threadIdx.x, wid = __builtin_amdgcn_readfirstlane(tid >> 6), lane = tid & 63, r32 = lane & 31, hi = lane >> 5;
    const int sr = tid >> 4, sc = (tid & 15) * 8, kws = KSWZ(sr, sc * 2); char* K_lds = lds + 2 * SHM_V;
    for (int d0 = 0; d0 < 8; ++d0) S.qr[d0] = load8(cur.Q + (size_t)(wid * QBLK + r32) * LDQ + d0 * 16 + hi * 8);
    SLOAD_H(cur.K, cur.V, cur.jlo * KVBLK); VMW(); SWRITE_HK(0);
    __syncthreads();
}
__device__ __forceinline__ void block(const BlockRef& cur, const BlockRef& nxt, char* lds, Seam& S) {
    int tid = threadIdx.x; asm volatile("" : "+v"(tid));
    const int wid = __builtin_amdgcn_readfirstlane(tid >> 6), lane = tid & 63, r32 = lane & 31, hi = lane >> 5;
    const int NT = cur.nt;
    char* V_lds = lds; char* K_lds = lds + 2 * SHM_V;
    float* ws = (float*)(lds + 2 * SHM_V + 2 * SHM_K) + wid * 64; float* li_l = ws, * al_l = ws + 32;
    float m_reg = -1e30f, l_reg = 0; f32x16 o[4] = {};
    const int sr = tid >> 4, sc = (tid & 15) * 8, vst0 = v_st(sr, sc), vst1 = v_st(32 + sr, sc), kws = KSWZ(sr, sc * 2);
    const int vb0 = (int)(uintptr_t)V_lds + v_rd_base(lane);
    const h16* Kh = cur.K; const h16* Vh = cur.V;
    const u64* mkp = cur.MK + (size_t)(wid * QBLK + r32) * 128;
#define RESC(a) do { if (__any((a) < 1.f)) { if (hi == 0) al_l[r32] = (a); asm volatile("s_waitcnt lgkmcnt(0)" ::: "memory");              \
                     for (int d_ = 0; d_ < 4; ++d_) for (int r = 0; r < 16; ++r) o[d_][r] *= al_l[crow(r, hi)]; } } while (0)
#define KBASE(t) ((cur.jlo + (t)) * KVBLK)
#define MLOAD(t) (mkp[cur.jlo + (t)])
    f32x16 pA0, pA1, pB0, pB1; float mnA, mnB, alA, alB; hx8 pa0, pa1, pa2, pa3; u64 mwA, mwB;
    SWRITE_HV(0); SBAR();
    mwA = MLOAD(0);
    if (NT > 1) { SLOAD_H(Kh, Vh, KBASE(1)); }
    SBAR(); qkt<0>(pA0, pA1, K_lds, r32, hi, S.qr);
    mask_bits(pA0, pA1, mwA, hi); partialSM(pA0, pA1, m_reg, mnA, alA);
    if (NT > 1) { VMW(); SWRITE_H(1); }
    __syncthreads();
#define HALF_STEP(PX0, PX1, mnX, alX, mwX, PY0, PY1, alY, t, KB, VB, SB) do {                                                      \
        SBAR(); mwX = MLOAD(t); qkt<KB>(PX0, PX1, K_lds, r32, hi, S.qr);                                             \
        finishSM(PY0, PY1, alY, l_reg, pa0, pa1, pa2, pa3); SBAR();                                                           \
        if ((t) + 1 < NT) { SLOAD_H(Kh, Vh, KBASE((t) + 1)); SBAR(); }                                               \
        pv_tile<VB>(o, vb0, pa0, pa1, pa2, pa3); mask_bits(PX0, PX1, mwX, hi); partialSM(PX0, PX1, m_reg, mnX, alX);                                        \
        __syncthreads();                                                                                                      \
        if ((t) + 1 < NT) { VMW(); SWRITE_H(SB); }                                                                          \
        RESC(alX); __syncthreads(); } while (0)
    for (int t = 1; t + 1 < NT; t += 2) {
        HALF_STEP(pB0, pB1, mnB, alB, mwB, pA0, pA1, alA, t, 1, 0, 0);
        HALF_STEP(pA0, pA1, mnA, alA, mwA, pB0, pB1, alB, t + 1, 0, 1, 1);
    }
    const bool even = (NT & 1) == 0;
    if (even) { SBAR(); mwB = MLOAD(NT - 1); qkt<1>(pB0, pB1, K_lds, r32, hi, S.qr); SBAR(); }
    SLOAD_H(nxt.K, nxt.V, nxt.jlo * KVBLK); SBAR();
#pragma unroll
    for (int d0 = 0; d0 < 8; ++d0) S.qr[d0] = load8(nxt.Q + (size_t)(wid * QBLK + r32) * LDQ + d0 * 16 + hi * 8);
    SBAR();
    finishSM(pA0, pA1, alA, l_reg, pa0, pa1, pa2, pa3); SBAR();
    pv_tile<0>(o, vb0, pa0, pa1, pa2, pa3);
    if (even) { mask_bits(pB0, pB1, mwB, hi); partialSM(pB0, pB1, m_reg, mnB, alB); __syncthreads(); RESC(alB);
        finishSM(pB0, pB1, alB, l_reg, pa0, pa1, pa2, pa3); SBAR(); pv_tile<1>(o, vb0, pa0, pa1, pa2, pa3); }
    SBAR(); VMWN(8); SWRITE_HK(0); SBAR();
    if (hi == 0) li_l[r32] = l_reg; asm volatile("s_waitcnt lgkmcnt(0)" ::: "memory");
    float rli[16];
#pragma unroll
    for (int r = 0; r < 16; ++r) { const float lv = li_l[crow(r, hi)]; rli[r] = lv > 0.f ? __builtin_amdgcn_rcpf(lv) : 0.f; }
    if (cur.ML && hi == 0) { float* mlp = cur.ML + (size_t)(wid * QBLK + r32) * 2; mlp[0] = m_reg; mlp[1] = l_reg; }
    const int LDO = cur.ldo;
    h16* Ow = cur.O + (size_t)(wid * QBLK) * LDO;
#pragma unroll
    for (int r = 0; r < 16; ++r) { const int orow = crow(r, hi);
#pragma unroll
        for (int d0 = 0; d0 < 4; ++d0) { const float v = o[d0][r] * rli[r];
            const float vn = __shfl_xor(v, 1);
            if ((r32 & 1) == 0) *(unsigned*)(Ow + (size_t)orow * LDO + d0 * 32 + r32) = cvtpk(v, vn); } }
    __syncthreads();
#undef RESC
#undef KBASE
#undef MLOAD
#undef HALF_STEP
}
#undef ROW
#undef VMW
#undef VMWN
#undef SLOAD_H
#undef SWRITE_HK
#undef SWRITE_HV
#undef SWRITE_H
#undef KSWZ
#undef SBAR
#undef MFMA32
}

namespace idx {
typedef unsigned short h16;
typedef short hx8 __attribute__((ext_vector_type(8)));
typedef _Float16 half8 __attribute__((ext_vector_type(8)));
typedef float f32x16 __attribute__((ext_vector_type(16)));
typedef __attribute__((address_space(3))) unsigned lds_u32;
constexpr int T = 8192, CAP = 512, TRIG = CAP - 96, WAVE_LDS = 8 * CAP * 4 + 256 + 64;
__device__ __forceinline__ unsigned tokey(float f) { const unsigned u = __float_as_uint(f); return (u & 0x80000000u) ? ~u : (u | 0x80000000u); }
__device__ __forceinline__ void lds_wait() { asm volatile("s_waitcnt lgkmcnt(0)" ::: "memory"); }

__device__ __forceinline__ unsigned radix_level(const unsigned (&keys)[8], unsigned alive, lds_u32* hist, int lane, int shift, unsigned dmask, int& K) {
    hist[lane] = 0u; lds_wait();
#pragma unroll
    for (int j = 0; j < 8; ++j) if ((alive >> j) & 1u) __hip_atomic_fetch_add((unsigned*)(hist + ((keys[j] >> shift) & dmask)), 1u, __ATOMIC_RELAXED, __HIP_MEMORY_SCOPE_WORKGROUP);
    lds_wait();
    unsigned suf = hist[lane];
#pragma unroll
    for (int o = 1; o < 64; o <<= 1) { const unsigned v = __shfl_down(suf, o); if (lane + o < 64) suf += v; }
    const unsigned long long bal = __ballot(suf >= (unsigned)K);
    const int d = __builtin_amdgcn_readfirstlane(63 - __builtin_clzll(bal | 1ull));
    const unsigned above = (d < 63) ? (unsigned)__builtin_amdgcn_readlane((int)suf, d + 1) : 0u;
    K -= (int)above;
    return (unsigned)d;
}
template <int NLEV>
__device__ __forceinline__ unsigned wave_select(const unsigned (&keys)[8], unsigned valid, lds_u32* hist, int lane, int& K) {
    unsigned prefix = 0u;
#pragma unroll
    for (int lv = 0; lv < NLEV; ++lv) {
        const int shift = lv == 0 ? 26 : lv == 1 ? 20 : lv == 2 ? 14 : lv == 3 ? 8 : lv == 4 ? 2 : 0, bits = lv == 5 ? 2 : 6;
        unsigned alive = valid;
        if (lv > 0) {
#pragma unroll
            for (int j = 0; j < 8; ++j) if ((keys[j] >> (shift + bits)) != prefix) alive &= ~(1u << j);
        }
        const unsigned d = radix_level(keys, alive, hist, lane, shift, (1u << bits) - 1u, K);
        prefix = (prefix << bits) | d;
    }
    return prefix;
}
__device__ __forceinline__ void load_buf(const lds_u32* bufq, int n, int lane, unsigned (&keys)[8], unsigned& valid) {
    valid = 0u;
#pragma unroll
    for (int j = 0; j < 8; ++j) { const int i = lane + 64 * j; if (i < n) { keys[j] = bufq[i]; valid |= 1u << j; } else keys[j] = 0u; }
    lds_wait();
}
__device__ __forceinline__ void compact(lds_u32* bufq, lds_u32* hist, int n, int lane, int& ncnt, unsigned& ntau) {
    unsigned keys[8], valid; load_buf(bufq, n, lane, keys, valid);
    int K = 256;
    const unsigned P = wave_select<3>(keys, valid, hist, lane, K);
    const unsigned tauq = P << 14;
    int base = 0;
#pragma unroll
    for (int j = 0; j < 8; ++j) {
        const bool keep = ((valid >> j) & 1u) && keys[j] >= tauq;
        const unsigned long long m = __ballot(keep);
        const int pos = base + (int)__builtin_amdgcn_mbcnt_hi((unsigned)(m >> 32), __builtin_amdgcn_mbcnt_lo((unsigned)m, 0u));
        if (keep) bufq[pos] = keys[j];
        base += __builtin_popcountll(m);
    }
    lds_wait();
    ncnt = base; ntau = tauq ? tauq - 1u : 0u;
    if (base > TRIG) {
        load_buf(bufq, base, lane, keys, valid);
        int K2 = 256;
        const unsigned tau = wave_select<6>(keys, valid, hist, lane, K2);
        int b2 = 0, eqleft = K2;
#pragma unroll
        for (int j = 0; j < 8; ++j) {
            const bool v = (valid >> j) & 1u;
            const bool gt = v && keys[j] > tau, eq = v && keys[j] == tau;
            const unsigned long long me = __ballot(eq);
            const int erank = (int)__builtin_amdgcn_mbcnt_hi((unsigned)(me >> 32), __builtin_amdgcn_mbcnt_lo((unsigned)me, 0u));
            const bool keep = gt || (eq && erank < eqleft);
            const unsigned long long m = __ballot(keep);
            const int pos = b2 + (int)__builtin_amdgcn_mbcnt_hi((unsigned)(m >> 32), __builtin_amdgcn_mbcnt_lo((unsigned)m, 0u));
            if (keep) bufq[pos] = keys[j];
            b2 += __builtin_popcountll(m);
            const int ne = __builtin_popcountll(me); eqleft = eqleft > ne ? eqleft - ne : 0;
        }
        lds_wait();
        ncnt = b2; ntau = tau;
    }
}

__device__ __forceinline__ int lane_of(int c, int hi) { return c + 32 * hi; }
__device__ __forceinline__ float fromkey(unsigned k) { return __uint_as_float((k & 0x80000000u) ? (k & 0x7fffffffu) : ~k); }
struct SelState { float tau[2][2]; int cnt[2][2]; int req[2][2]; int eqs[2][2]; };
template <int PASS>
__device__ __forceinline__ void tile_step(const hx8 (&bf)[4], int jt, int lo_tiles, const hx8 (&af)[2][4], const float (&wv)[2][2][8], const int (&tq)[2][2], SelState& st,
                                          lds_u32* buf, int (&W)[2][2], int c, int hi) {
    const int sidx = jt * 32 + c;
    const bool mine = c == (jt & 31);
#pragma unroll
    for (int g = 0; g < 2; ++g) {
        if (g == 0 && jt >= lo_tiles) continue;
        f32x16 acc = {};
#pragma unroll
        for (int ks = 0; ks < 4; ++ks) acc = __builtin_amdgcn_mfma_f32_32x32x16_f16(__builtin_bit_cast(half8, af[g][ks]), __builtin_bit_cast(half8, bf[ks]), acc, 0, 0, 0);
        float sc[2] = {0.f, 0.f};
#pragma unroll
        for (int h = 0; h < 8; ++h) {
            sc[0] = fmaf(wv[g][0][h], __int_as_float(max(__float_as_int(acc[h]), 0)), sc[0]);
            sc[1] = fmaf(wv[g][1][h], __int_as_float(max(__float_as_int(acc[8 + h]), 0)), sc[1]);
        }
#pragma unroll
        for (int e = 0; e < 2; ++e) {
            const unsigned long long vm = __builtin_amdgcn_ballot_w64(sidx <= tq[g][e]);
            if (PASS == 1) {
                const unsigned long long m = __builtin_amdgcn_ballot_w64(sc[e] > st.tau[g][e]) & vm;
                if (m) {
                    const unsigned mlo = (unsigned)m, mhi = (unsigned)(m >> 32);
                    const int plo = (int)__builtin_amdgcn_mbcnt_lo(mlo, 0u), phi = (int)__builtin_amdgcn_mbcnt_hi(mhi, 0u);
                    const int pre = hi ? phi : plo;
                    if ((m >> lane_of(c, hi)) & 1ull) buf[(g * 4 + 2 * hi + e) * CAP + st.cnt[g][e] + pre] = tokey(sc[e]);
                    const int nlo = __builtin_popcount(mlo), nhi = __builtin_popcount(mhi);
                    st.cnt[g][e] += hi ? nhi : nlo;
                }
            } else {
                unsigned long long ms = __builtin_amdgcn_ballot_w64(sc[e] > st.tau[g][e]) & vm;
                const unsigned long long me = __builtin_amdgcn_ballot_w64(sc[e] == st.tau[g][e]) & vm;
                if (me) {
                    const unsigned elo = (unsigned)me, ehi = (unsigned)(me >> 32);
                    const int plo = (int)__builtin_amdgcn_mbcnt_lo(elo, 0u), phi = (int)__builtin_amdgcn_mbcnt_hi(ehi, 0u);
                    const int er = st.eqs[g][e] + (hi ? phi : plo);
                    ms |= __builtin_amdgcn_ballot_w64(((me >> lane_of(c, hi)) & 1ull) && er < st.req[g][e]);
                    const int nlo = __builtin_popcount(elo), nhi = __builtin_popcount(ehi);
                    st.eqs[g][e] += hi ? nhi : nlo;
                }
                const int wlo = (int)(unsigned)ms, whi = (int)(unsigned)(ms >> 32);
                const int wsel = hi ? whi : wlo;
                W[g][e] = mine ? wsel : W[g][e];
            }
        }
    }
}
__device__ __forceinline__ void compact_slots(SelState& st, lds_u32* buf, lds_u32* hist, lds_u32* ctl, int lane, int c, int hi) {
    if (c == 0) {
#pragma unroll
        for (int g = 0; g < 2; ++g)
#pragma unroll
            for (int e = 0; e < 2; ++e) { ctl[g * 4 + 2 * hi + e] = (unsigned)st.cnt[g][e]; ctl[8 + g * 4 + 2 * hi + e] = __float_as_uint(st.tau[g][e]); }
    }
    lds_wait();
#pragma unroll 1
    for (int qs = 0; qs < 8; ++qs) {
        const int n = __builtin_amdgcn_readfirstlane((int)ctl[qs]);
        if (n > TRIG) {
            int ncnt; unsigned ntau;
            compact(buf + qs * CAP, hist, n, lane, ncnt, ntau);
            if (lane == 0) { ctl[qs] = (unsigned)ncnt; ctl[8 + qs] = __float_as_uint(ntau < 0x00800000u ? -__builtin_inff() : fromkey(ntau)); }
        }
    }
    lds_wait();
#pragma unroll
    for (int g = 0; g < 2; ++g)
#pragma unroll
        for (int e = 0; e < 2; ++e) { st.cnt[g][e] = (int)ctl[g * 4 + 2 * hi + e]; st.tau[g][e] = __uint_as_float(ctl[8 + g * 4 + 2 * hi + e]); }
    lds_wait();
}
template <int PASS>
__device__ __forceinline__ void key_sweep(const h16* __restrict__ kp, int ntiles, int lo_tiles, const hx8 (&af)[2][4], const float (&wv)[2][2][8], const int (&tq)[2][2], SelState& st,
                                          lds_u32* buf, lds_u32* hist, lds_u32* ctl, unsigned* __restrict__ MASK32, int b, int lane, int c, int hi) {
#define IDX_LOADT(dst, t) do { const int tt_ = (t) < ntiles ? (t) : ntiles - 1; _Pragma("unroll") for (int ks = 0; ks < 4; ++ks) dst[ks] = *(const hx8*)(kp + (size_t)tt_ * 2048 + ks * 512); } while (0)
#define IDX_FLUSH(t) do { if (PASS == 2 && ((((t) & 31) == 31) || (t) == ntiles - 1)) { const int gb_ = (t) & ~31; \
        _Pragma("unroll") for (int g = 0; g < 2; ++g) { if (g == 0 && gb_ >= lo_tiles) continue; \
            _Pragma("unroll") for (int e = 0; e < 2; ++e) { MASK32[((size_t)(b * T + tq[g][e])) * 256 + gb_ + c] = (unsigned)W[g][e]; W[g][e] = 0; } } } } while (0)
    hx8 bA[4], bB[4], bC[4];
    int W[2][2] = {{0, 0}, {0, 0}};
    IDX_LOADT(bA, 0); IDX_LOADT(bB, 1);
#pragma unroll 1
    for (int jt = 0; jt < ntiles; jt += 3) {
        IDX_LOADT(bC, jt + 2);
        tile_step<PASS>(bA, jt, lo_tiles, af, wv, tq, st, buf, W, c, hi); IDX_FLUSH(jt);
        if (jt + 1 < ntiles) { IDX_LOADT(bA, jt + 3); tile_step<PASS>(bB, jt + 1, lo_tiles, af, wv, tq, st, buf, W, c, hi); IDX_FLUSH(jt + 1); }
        if (jt + 2 < ntiles) { IDX_LOADT(bB, jt + 4); tile_step<PASS>(bC, jt + 2, lo_tiles, af, wv, tq, st, buf, W, c, hi); IDX_FLUSH(jt + 2); }
        if (PASS == 1) {
            const bool need = st.cnt[0][0] > TRIG || st.cnt[0][1] > TRIG || st.cnt[1][0] > TRIG || st.cnt[1][1] > TRIG;
            if (__builtin_amdgcn_ballot_w64(need)) compact_slots(st, buf, hist, ctl, lane, c, hi);
        }
    }
#undef IDX_LOADT
#undef IDX_FLUSH
}
__device__ __forceinline__ void select_task(int task, __attribute__((address_space(3))) unsigned char* wl, const h16* __restrict__ IQ, const h16* __restrict__ IK,
                                            const float* __restrict__ IW, unsigned* __restrict__ MASK32, int lane) {
    lds_u32* buf = (lds_u32*)wl; lds_u32* hist = (lds_u32*)(wl + 8 * CAP * 4); lds_u32* ctl = hist + 64;
    const int b = task >> 10, i = task & 1023, c = lane & 31, hi = lane >> 5;
    const int qp0 = 4 * i, qp1 = 8188 - 4 * i;
    hx8 af[2][4]; float wv[2][2][8]; int tq[2][2];
    {
        const int rho = c, qloc = 2 * ((rho >> 2) & 1) + (rho >> 4), head = (rho & 3) + 4 * ((rho >> 3) & 1);
#pragma unroll
        for (int g = 0; g < 2; ++g) {
            const int qp = g ? qp1 : qp0;
#pragma unroll
            for (int ks = 0; ks < 4; ++ks) af[g][ks] = *(const hx8*)(IQ + ((size_t)(b * T + qp + qloc)) * 512 + head * 64 + ks * 16 + 8 * hi);
#pragma unroll
            for (int e = 0; e < 2; ++e) {
                tq[g][e] = qp + 2 * hi + e;
#pragma unroll
                for (int h = 0; h < 8; ++h) wv[g][e][h] = IW[((size_t)(b * T + qp + 2 * hi + e)) * 8 + h];
            }
        }
    }
    const int ntiles = (qp1 + 3) / 32 + 1, lo_tiles = (qp0 + 3) / 32 + 1;
    const h16* kp = IK + (size_t)b * T * 64 + lane * 8;
    SelState st;
#pragma unroll
    for (int g = 0; g < 2; ++g)
#pragma unroll
        for (int e = 0; e < 2; ++e) { st.tau[g][e] = -__builtin_inff(); st.cnt[g][e] = 0; st.req[g][e] = 0; st.eqs[g][e] = 0; }
    key_sweep<1>(kp, ntiles, lo_tiles, af, wv, tq, st, buf, hist, ctl, MASK32, b, lane, c, hi);
    if (c == 0) {
#pragma unroll
        for (int g = 0; g < 2; ++g)
#pragma unroll
            for (int e = 0; e < 2; ++e) ctl[g * 4 + 2 * hi + e] = (unsigned)st.cnt[g][e];
    }
    lds_wait();
#pragma unroll 1
    for (int qs = 0; qs < 8; ++qs) {
        const int n = __builtin_amdgcn_readfirstlane((int)ctl[qs]);
        const int tqq = ((qs >> 2) ? qp1 : qp0) + (qs & 3);
        float ft = -__builtin_inff(); int fr = 0;
        if (tqq >= 256) {
            unsigned keys[8], valid; load_buf(buf + qs * CAP, n, lane, keys, valid);
            int K = 256;
            ft = fromkey(wave_select<6>(keys, valid, hist, lane, K)); fr = K;
        }
        if (lane == 0) { ctl[qs] = (unsigned)fr; ctl[8 + qs] = __float_as_uint(ft); }
    }
    lds_wait();
#pragma unroll
    for (int g = 0; g < 2; ++g)
#pragma unroll
        for (int e = 0; e < 2; ++e) { st.req[g][e] = (int)ctl[g * 4 + 2 * hi + e]; st.tau[g][e] = __uint_as_float(ctl[8 + g * 4 + 2 * hi + e]); }
    lds_wait();
    key_sweep<2>(kp, ntiles, lo_tiles, af, wv, tq, st, buf, hist, ctl, MASK32, b, lane, c, hi);
}
}

namespace hg {
typedef unsigned short h16;
typedef short hx8 __attribute__((ext_vector_type(8)));
typedef _Float16 half8 __attribute__((ext_vector_type(8)));
typedef float f32x16 __attribute__((ext_vector_type(16)));
typedef unsigned u32x4 __attribute__((ext_vector_type(4)));
typedef __attribute__((address_space(3))) unsigned char lds_u8;
constexpr int T = 8192, LDP = 136, LDS_S = 72;
constexpr int OFF_PART = 0, OFF_VT = 2048, OFF_KST = 20480;
constexpr int OFF_QIN = 20480, OFF_QD = 37888, OFF_KD = 55296, OFF_QO = 72704, OFF_KO = 81408, OFF_A = 90112, OFF_O = 99328;
__device__ __forceinline__ float h2f(h16 v) { return (float)__builtin_bit_cast(_Float16, v); }
__device__ __forceinline__ h16 f2h(float v) { return __builtin_bit_cast(h16, (_Float16)v); }
__device__ __forceinline__ h16 f2bf(float f) { const unsigned u = __float_as_uint(f); return (h16)((u + 0x7fffu + ((u >> 16) & 1u)) >> 16); }
__device__ __forceinline__ int crow(int r, int hi) { return (r & 3) + 8 * (r >> 2) + 4 * hi; }
#define HG_MFMA_F16(a, b, c) __builtin_amdgcn_mfma_f32_32x32x16_f16(__builtin_bit_cast(half8, a), __builtin_bit_cast(half8, b), c, 0, 0, 0)
#define HG_MFMA_BF16(a, b, c) __builtin_amdgcn_mfma_f32_32x32x16_bf16(a, b, c, 0, 0, 0)

__device__ __forceinline__ void head(lds_u8* lds, const h16* __restrict__ LF, const h16* __restrict__ V, size_t row0, int col0, int tid, float (&lf)[16], float (&g)[16], float (&ps)[4]) {
    const int k = tid & 127, p = tid >> 7;
    __attribute__((address_space(3))) float* part = (__attribute__((address_space(3))) float*)(lds + OFF_PART);
    __attribute__((address_space(3))) h16* vT = (__attribute__((address_space(3))) h16*)(lds + OFF_VT);
    float run = 0.f;
#pragma unroll
    for (int i = 0; i < 16; ++i) { lf[i] = h2f(LF[(row0 + 16 * p + i) * 512 + col0 + k]); run += lf[i]; g[i] = run; }
    part[p * 128 + k] = run;
#pragma unroll
    for (int u = 0; u < 2; ++u) {
        const int idx = tid + 512 * u, sidx = idx >> 4, d8 = (idx & 15) * 8;
        const u32x4 w = *(const u32x4*)(V + (row0 + sidx) * 512 + col0 + d8);
        const unsigned ww[4] = {w.x, w.y, w.z, w.w};
#pragma unroll
        for (int e = 0; e < 4; ++e) { vT[(d8 + 2 * e) * LDS_S + sidx] = (h16)(ww[e] & 0xffff); vT[(d8 + 2 * e + 1) * LDS_S + sidx] = (h16)(ww[e] >> 16); }
    }
    __syncthreads();
#pragma unroll
    for (int q = 0; q < 4; ++q) ps[q] = part[q * 128 + k];
    float off = 0.f;
#pragma unroll
    for (int q = 0; q < 4; ++q) if (q < p) off += ps[q];
#pragma unroll
    for (int i = 0; i < 16; ++i) g[i] += off;
}

__device__ __forceinline__ void h1_task(int task, lds_u8* lds, const h16* __restrict__ LF, const h16* __restrict__ V, h16* __restrict__ UST, float* __restrict__ DEC) {
    int tid = threadIdx.x; asm volatile("" : "+v"(tid));
    const int lane = tid & 63, wave = __builtin_amdgcn_readfirstlane(tid >> 6), r = lane & 31, hi = lane >> 5;
    const int bh = task >> 7, c = task & 127, b = bh >> 2, h = bh & 3, k = tid & 127, p = tid >> 7;
    const size_t row0 = (size_t)b * T + c * 64; const int col0 = h * 128;
    float lf[16], g[16], ps[4];
    head(lds, LF, V, row0, col0, tid, lf, g, ps);
    const float gtot = (ps[0] + ps[1]) + (ps[2] + ps[3]);
    __attribute__((address_space(3))) h16* kst = (__attribute__((address_space(3))) h16*)(lds + OFF_KST);
    {
        unsigned w[8];
#pragma unroll
        for (int i = 0; i < 16; i += 2) {
            const float a0 = (1.f - __expf(lf[i])) * __expf(gtot - g[i]), a1 = (1.f - __expf(lf[i + 1])) * __expf(gtot - g[i + 1]);
            w[i >> 1] = (unsigned)f2h(a0) | ((unsigned)f2h(a1) << 16);
        }
        __attribute__((address_space(3))) u32x4* dst = (__attribute__((address_space(3))) u32x4*)(kst + k * LDS_S + 16 * p);
        dst[0] = (u32x4){w[0], w[1], w[2], w[3]}; dst[1] = (u32x4){w[4], w[5], w[6], w[7]};
    }
    if (p == 0) DEC[(size_t)task * 128 + k] = __expf(gtot);
    __syncthreads();
    const __attribute__((address_space(3))) h16* vT = (const __attribute__((address_space(3))) h16*)(lds + OFF_VT);
    const int vi = wave >> 1;
#pragma unroll
    for (int tt = 0; tt < 2; ++tt) {
        const int kj = (wave & 1) * 2 + tt;
        f32x16 acc = {};
#pragma unroll
        for (int ks = 0; ks < 4; ++ks) {
            const hx8 af = *(const __attribute__((address_space(3))) hx8*)(vT + (32 * vi + r) * LDS_S + ks * 16 + 8 * hi);
            const hx8 bf = *(const __attribute__((address_space(3))) hx8*)(kst + (32 * kj + r) * LDS_S + ks * 16 + 8 * hi);
            acc = HG_MFMA_F16(af, bf, acc);
        }
        h16* dst = UST + ((size_t)task * 128 + 32 * vi) * 128 + 32 * kj + r;
#pragma unroll
        for (int rg = 0; rg < 16; ++rg) dst[(size_t)crow(rg, hi) * 128] = f2h(acc[rg]);
    }
    __syncthreads();
}

__device__ __forceinline__ void h2_scan(int gtid, int gthreads, h16* __restrict__ UST, const float* __restrict__ DEC) {
    for (int id = gtid; id < 8 * 16384; id += gthreads) {
        const int bh = id >> 14, e = id & 16383, k = e & 127;
        float S = 0.f;
        h16* up = UST + (size_t)bh * 128 * 16384 + e; const float* dp = DEC + (size_t)bh * 128 * 128 + k;
#pragma unroll 8
        for (int c = 0; c < 128; ++c) {
            const float u = h2f(up[(size_t)c * 16384]), d = dp[c * 128];
            up[(size_t)c * 16384] = f2h(S);
            S = fmaf(d, S, u);
        }
    }
}

__device__ __forceinline__ void h3_task(int task, lds_u8* lds, const h16* __restrict__ QH, const h16* __restrict__ LF, const h16* __restrict__ V, const h16* __restrict__ Gt,
                                        const h16* __restrict__ UST, const float* __restrict__ onorm, h16* __restrict__ OM) {
    int tid = threadIdx.x; asm volatile("" : "+v"(tid));
    const int lane = tid & 63, wave = __builtin_amdgcn_readfirstlane(tid >> 6), r = lane & 31, hi = lane >> 5;
    const int bh = task >> 7, c = task & 127, b = bh >> 2, h = bh & 3, k = tid & 127, p = tid >> 7;
    const size_t row0 = (size_t)b * T + c * 64; const int col0 = h * 128;
    float lf[16], g[16], ps[4];
    head(lds, LF, V, row0, col0, tid, lf, g, ps);
    const float R0 = ps[0], G31 = ps[0] + ps[1], R1 = G31 + ps[2], Ri = p < 2 ? R0 : R1;
    __attribute__((address_space(3))) h16* QIN = (__attribute__((address_space(3))) h16*)(lds + OFF_QIN);
    __attribute__((address_space(3))) h16* QD = (__attribute__((address_space(3))) h16*)(lds + OFF_QD);
    __attribute__((address_space(3))) h16* KD = (__attribute__((address_space(3))) h16*)(lds + OFF_KD);
    __attribute__((address_space(3))) h16* QO = (__attribute__((address_space(3))) h16*)(lds + OFF_QO);
    __attribute__((address_space(3))) h16* KO = (__attribute__((address_space(3))) h16*)(lds + OFF_KO);
    __attribute__((address_space(3))) h16* AM = (__attribute__((address_space(3))) h16*)(lds + OFF_A);
    __attribute__((address_space(3))) float* OB = (__attribute__((address_space(3))) float*)(lds + OFF_O);
#pragma unroll
    for (int i = 0; i < 16; ++i) {
        const int t = 16 * p + i;
        const float q = h2f(QH[(row0 + t) * 512 + col0 + k]), kk = 1.f - __expf(lf[i]), gi = g[i];
        QIN[t * LDP + k] = f2h(q * __expf(gi));
        QD[t * LDP + k] = f2bf(q * __expf(fminf(fmaxf(gi - Ri, -80.f), 80.f)));
        KD[t * LDP + k] = f2bf(kk * __expf(fminf(fmaxf(Ri - gi, -80.f), 80.f)));
        if (p >= 2) QO[(t - 32) * LDP + k] = f2h(q * __expf(gi - G31));
        else KO[t * LDP + k] = f2h(kk * __expf(G31 - gi));
    }
    __syncthreads();
    if (wave < 2) {
        const int o0 = 32 * wave;
        f32x16 acc = {};
#pragma unroll
        for (int ks = 0; ks < 8; ++ks) {
            const hx8 af = *(const __attribute__((address_space(3))) hx8*)(QD + (o0 + r) * LDP + ks * 16 + 8 * hi);
            const hx8 bf = *(const __attribute__((address_space(3))) hx8*)(KD + (o0 + r) * LDP + ks * 16 + 8 * hi);
            acc = HG_MFMA_BF16(af, bf, acc);
        }
#pragma unroll
        for (int rg = 0; rg < 16; ++rg) { const int t = crow(rg, hi); AM[(o0 + t) * LDS_S + o0 + r] = (r <= t) ? f2h(acc[rg]) : (h16)0; }
    } else if (wave == 2) {
        f32x16 acc = {};
#pragma unroll
        for (int ks = 0; ks < 8; ++ks) {
            const hx8 af = *(const __attribute__((address_space(3))) hx8*)(QO + r * LDP + ks * 16 + 8 * hi);
            const hx8 bf = *(const __attribute__((address_space(3))) hx8*)(KO + r * LDP + ks * 16 + 8 * hi);
            acc = HG_MFMA_F16(af, bf, acc);
        }
#pragma unroll
        for (int rg = 0; rg < 16; ++rg) AM[(32 + crow(rg, hi)) * LDS_S + r] = f2h(acc[rg]);
    } else if (wave == 3) {
#pragma unroll
        for (int rg = 0; rg < 16; ++rg) AM[crow(rg, hi) * LDS_S + 32 + r] = (h16)0;
    }
    __syncthreads();
    {
        const int ti = wave >> 2, vi = wave & 3;
        const __attribute__((address_space(3))) h16* vT = (const __attribute__((address_space(3))) h16*)(lds + OFF_VT);
        f32x16 acc = {};
        const h16* sp = UST + ((size_t)task * 128 + 32 * vi + r) * 128 + 8 * hi;
#pragma unroll
        for (int ks = 0; ks < 8; ++ks) {
            const hx8 af = *(const __attribute__((address_space(3))) hx8*)(QIN + (32 * ti + r) * LDP + ks * 16 + 8 * hi);
            const hx8 bf = *(const hx8*)(sp + ks * 16);
            acc = HG_MFMA_F16(af, bf, acc);
        }
#pragma unroll
        for (int ks = 0; ks < 4; ++ks) {
            const hx8 af = *(const __attribute__((address_space(3))) hx8*)(AM + (32 * ti + r) * LDS_S + ks * 16 + 8 * hi);
            const hx8 bf = *(const __attribute__((address_space(3))) hx8*)(vT + (32 * vi + r) * LDS_S + ks * 16 + 8 * hi);
            acc = HG_MFMA_F16(af, bf, acc);
        }
#pragma unroll
        for (int rg = 0; rg < 16; ++rg) OB[(32 * ti + crow(rg, hi)) * 132 + 32 * vi + r] = acc[rg];
    }
    __syncthreads();
#pragma unroll
    for (int rr = 0; rr < 8; ++rr) {
        const int row = 8 * wave + rr;
        const float x0 = OB[row * 132 + 2 * lane], x1 = OB[row * 132 + 2 * lane + 1];
        float ss = x0 * x0 + x1 * x1;
#pragma unroll
        for (int o = 1; o < 64; o <<= 1) ss += __shfl_xor(ss, o);
        const float rn = rsqrtf(ss * (1.f / 128.f) + 1e-6f);
        const unsigned gg = *(const unsigned*)(Gt + (row0 + row) * 512 + col0 + 2 * lane);
        const float o0 = x0 * rn * onorm[col0 + 2 * lane] * h2f((h16)(gg & 0xffff)), o1 = x1 * rn * onorm[col0 + 2 * lane + 1] * h2f((h16)(gg >> 16));
        *(unsigned*)(OM + (row0 + row) * 1024 + col0 + 2 * lane) = (unsigned)f2h(o0) | ((unsigned)f2h(o1) << 16);
    }
    __syncthreads();
}
#undef HG_MFMA_F16
#undef HG_MFMA_BF16
}

namespace {
constexpr int B_ = 2, T_ = 8192, D_ = 1024, M_ = B_ * T_;
constexpr int DIN = 4168, DIN_PAD = 4352, DFF = 2816;
constexpr float EPS = 1e-6f;
constexpr int NWAVES = 8, NTHR = 512;

#define GAS __attribute__((address_space(1)))
#define LAS __attribute__((address_space(3)))
typedef unsigned short h16;
typedef float f32x4 __attribute__((ext_vector_type(4)));
typedef unsigned u32x4 __attribute__((ext_vector_type(4)));
typedef unsigned u32x2 __attribute__((ext_vector_type(2)));

__constant__ float c_inv16[16] = {1.f, 0.440366596f, 0.193922743f, 0.0853971019f, 0.0376060307f, 0.0165604409f, 0.00729266461f, 0.00321144611f,
                                  0.00141421356f, 0.000622772437f, 0.000274248188f, 0.000120769735f, 5.31829573e-05f, 2.34199997e-05f, 1.03133852e-05f, 4.54167048e-06f};
__constant__ float c_inv8[8] = {1.f, 0.193922743f, 0.0376060307f, 0.00729266461f, 0.00141421356f, 0.000274248188f, 5.31829573e-05f, 1.03133852e-05f};

__constant__ signed char c_att_tab[32][2][4] = {
{{31,64,64,1},{-1,0,0,0}}, {{31,0,64,0},{-1,0,0,0}}, {{30,62,62,1},{-1,0,0,0}}, {{30,0,62,0},{-1,0,0,0}}, {{29,60,60,1},{-1,0,0,0}}, {{29,0,60,0},{-1,0,0,0}}, {{28,58,58,1},{-1,0,0,0}}, {{28,0,58,0},{-1,0,0,0}},
{{27,56,56,1},{1,0,8,-1}}, {{27,0,56,0},{0,0,4,-1}}, {{26,54,54,1},{3,0,16,-1}}, {{26,0,54,0},{2,0,12,-1}}, {{25,52,52,1},{8,18,18,1}}, {{25,0,52,0},{8,0,18,0}}, {{24,50,50,1},{9,0,20,0}}, {{24,0,50,0},{4,0,20,-1}},
{{23,48,48,1},{10,0,22,0}}, {{23,0,48,0},{9,20,20,1}}, {{22,46,46,1},{5,0,24,-1}}, {{22,0,46,0},{10,22,22,1}}, {{21,44,44,1},{11,24,24,1}}, {{21,0,44,0},{11,0,24,0}}, {{20,42,42,1},{12,26,26,1}}, {{20,0,42,0},{12,0,26,0}},
{{19,40,40,1},{13,0,28,0}}, {{19,0,40,0},{6,0,28,-1}}, {{18,38,38,1},{14,0,30,0}}, {{18,0,38,0},{13,28,28,1}}, {{17,36,36,1},{7,0,32,-1}}, {{17,0,36,0},{14,30,30,1}}, {{16,34,34,1},{15,32,32,1}}, {{16,0,34,0},{15,0,32,0}}};

constexpr size_t MiB = 1u << 20;
constexpr size_t WS_CTL = 0, CTL_ZERO_BYTES = 1 * MiB;
constexpr size_t WS_MOD = 1 * MiB, WS_LB = 1 * MiB + 64 * 1024;
constexpr size_t WS_WIN = 2 * MiB, WS_WOUT = 11 * MiB, WS_WF1 = 13 * MiB, WS_WF2 = 24 * MiB;
constexpr size_t WS_XN = 30 * MiB;
constexpr size_t WS_GRP = 62 * MiB, GRP_STRIDE = 16 * MiB;
constexpr size_t WS_IK = 190 * MiB, WS_IW = 192 * MiB, WS_IKRAW = 193 * MiB;
constexpr size_t WS_UST = 197 * MiB;
constexpr size_t WS_DEC = 193 * MiB;
constexpr size_t WS_Y = 62 * MiB;
constexpr size_t WS_ACT = 126 * MiB;
constexpr size_t WS_MASK = 229 * MiB;
constexpr size_t WS_PART = 174 * MiB;
constexpr size_t WS_ML = 245 * MiB;
constexpr size_t WS_END = 246 * MiB;
constexpr int CW_BAR = 4096;

constexpr int RING_BYTES = 135168, LDSCTL_OFF = RING_BYTES, MISC_OFF = LDSCTL_OFF + 320, LDS_BYTES = 139264;

__device__ __forceinline__ float wave_sum(float v) {
#pragma unroll
    for (int o = 1; o < 64; o <<= 1) v += __shfl_xor(v, o);
    return v;
}
__device__ __forceinline__ float wave_max(float v) {
#pragma unroll
    for (int o = 1; o < 64; o <<= 1) v = fmaxf(v, __shfl_xor(v, o));
    return v;
}
__device__ __forceinline__ float sigmoidf_(float v) { return 1.f / (1.f + expf(-v)); }
__device__ __forceinline__ float siluf_(float v) { return v / (1.f + expf(-v)); }
__device__ __forceinline__ unsigned pk_f16(float lo, float hi) {
    typedef _Float16 h2 __attribute__((ext_vector_type(2))); typedef float f2 __attribute__((ext_vector_type(2)));
    const h2 h = __builtin_convertvector((f2){lo, hi}, h2); return __builtin_bit_cast(unsigned, h);
}
__device__ __forceinline__ float h2f(h16 v) { return (float)__builtin_bit_cast(_Float16, v); }
__device__ __forceinline__ h16 f2h(float v) { return __builtin_bit_cast(h16, (_Float16)v); }

__device__ __forceinline__ void sincos_acc(float ang, float& s, float& c) {
    const double a = (double)ang;
    const double n = rint(a * 0.63661977236758134308);
    double y = fma(-n, 1.57079632679489655800, a);
    y = fma(-n, 6.12323399573676603587e-17, y);
    const int q = (int)((long long)n & 3);
    const double y2 = y * y;
    const double sp = y * (1.0 + y2 * (-1.0 / 6.0 + y2 * (1.0 / 120.0 + y2 * (-1.0 / 5040.0 + y2 * (1.0 / 362880.0 + y2 * (-1.0 / 39916800.0 + y2 * (1.0 / 6227020800.0 + y2 * (-1.0 / 1307674368000.0))))))));
    const double cp = 1.0 + y2 * (-0.5 + y2 * (1.0 / 24.0 + y2 * (-1.0 / 720.0 + y2 * (1.0 / 40320.0 + y2 * (-1.0 / 3628800.0 + y2 * (1.0 / 479001600.0 + y2 * (-1.0 / 87178291200.0)))))));
    double sd, cd;
    if (q == 0) { sd = sp; cd = cp; } else if (q == 1) { sd = cp; cd = -sp; } else if (q == 2) { sd = -sp; cd = -cp; } else { sd = -cp; cd = sp; }
    s = (float)sd; c = (float)cd;
}

#define XB_TMO      128
#define XB_XCNT(j)  (256  + 64 * (j))
#define XB_XSUB(j)  (1280 + 64 * (j))
#define XB_XGEN(j)  (2304 + 64 * (j))
#define XB_TOP      3328
#define XB_TOPGEN   3392
#define XCD_BAR_WORDS 3456
#define XB_SPIN_CAP (1u << 22)
__device__ __forceinline__ unsigned xb_ld(unsigned* p)              { return __hip_atomic_load(p, __ATOMIC_RELAXED, __HIP_MEMORY_SCOPE_AGENT); }
__device__ __forceinline__ unsigned xb_add(unsigned* p, unsigned v) { return __hip_atomic_fetch_add(p, v, __ATOMIC_RELAXED, __HIP_MEMORY_SCOPE_AGENT); }
__device__ __forceinline__ unsigned xb_xcc_id() { return (unsigned)__builtin_amdgcn_s_getreg((3 << 11) | 20) & 0xFu; }
#define XB_SPIN(cond, bar) do { unsigned _sp = 0; while (cond) { __builtin_amdgcn_s_sleep(1); \
    if ((++_sp & 255u) == 0u) { if (xb_ld(&(bar)[XB_TMO])) break; if (_sp > XB_SPIN_CAP) { atomicAdd(&(bar)[XB_TMO], 1u); break; } } } } while (0)
struct XcdBarrier { unsigned* bar; unsigned x; volatile LAS unsigned* st; };
__device__ __forceinline__ XcdBarrier xcd_barrier_post(unsigned* bar, volatile LAS unsigned* st) {
    XcdBarrier b; b.bar = bar; b.x = xb_xcc_id(); b.st = st;
    if (threadIdx.x == 0) (void)xb_add(&bar[XB_XCNT(b.x)], 1u);
    return b;
}
__device__ __forceinline__ void xcd_barrier_complete(unsigned* bar, unsigned x, unsigned& nloc, unsigned& nx) {
    const unsigned G = gridDim.x * gridDim.y * gridDim.z;
    unsigned sum, cnt, mine, sp = 0u;
    for (;;) {
        sum = 0u; cnt = 0u; mine = 0u;
#pragma unroll
        for (unsigned j = 0; j < 16; ++j) { const unsigned c = xb_ld(&bar[XB_XCNT(j)]); sum += c; cnt += (c > 0u) ? 1u : 0u; mine = (j == x) ? c : mine; }
        if (sum == G) break;
        __builtin_amdgcn_s_sleep(1);
        if ((++sp & 255u) == 0u) { if (xb_ld(&bar[XB_TMO])) break; if (sp > XB_SPIN_CAP) { atomicAdd(&bar[XB_TMO], 1u); break; } }
    }
    nloc = mine > 0u ? mine : 1u; nx = cnt > 0u ? cnt : 1u;
}
__device__ __forceinline__ void xcd_barrier(const XcdBarrier& b) {
    asm volatile("s_waitcnt vmcnt(0)" ::: "memory");
    __syncthreads();
    if (threadIdx.x == 0) {
        unsigned* bar = b.bar;
        __builtin_amdgcn_s_waitcnt(0);
        unsigned nloc = b.st[0], nx = b.st[1];
        if (nloc == 0u) { xcd_barrier_complete(bar, b.x, nloc, nx); b.st[0] = nloc; b.st[1] = nx; }
        const unsigned old = xb_add(&bar[XB_XSUB(b.x)], 1u);
        const unsigned gen = old / nloc;
        if (old + 1u == (gen + 1u) * nloc) {
            __builtin_amdgcn_fence(__ATOMIC_RELEASE, "agent");
            asm volatile("s_waitcnt vmcnt(0)" ::: "memory");
            const unsigned og = xb_add(&bar[XB_TOP], 1u);
            const unsigned tg = og / nx;
            if (og + 1u == (tg + 1u) * nx) xb_add(&bar[XB_TOPGEN], 1u);
            else XB_SPIN(xb_ld(&bar[XB_TOPGEN]) == tg, bar);
            __builtin_amdgcn_fence(__ATOMIC_ACQUIRE, "agent");
            xb_add(&bar[XB_XGEN(b.x)], 1u);
            asm volatile("s_waitcnt vmcnt(0)" ::: "memory");
        } else {
            XB_SPIN(xb_ld(&bar[XB_XGEN(b.x)]) == gen, bar);
            __builtin_amdgcn_fence(__ATOMIC_ACQUIRE, "agent");
            asm volatile("s_waitcnt vmcnt(0)" ::: "memory");
        }
    }
    __syncthreads();
}

struct EpiIn16 {
    static constexpr bool PERM = true, AFTER_DRAIN = false;
    h16* grp; float* IKRAW; float* IW; const float* lb;
    __device__ __forceinline__ void operator()(const f32x4 (&acc)[2][2][4][2], const pg8::Unit& u, int wr, int wc, int fr, int fq) const {
        const int row0 = u.pm * 256 + wr * 64 + fr;
        if (u.pn < 16) {
            const int g = u.pn >> 1;
            const int jc0 = (u.pn & 1) * 256 + wc * 32 + 8 * fq;
            h16* gb = grp + (size_t)g * ((size_t)M_ * 512);
            float lbv[2][8];
            if (g == 1) {
#pragma unroll
                for (int bj = 0; bj < 2; ++bj)
#pragma unroll
                    for (int e = 0; e < 8; ++e) lbv[bj][e] = lb[jc0 + bj * 128 + e];
            }
#pragma unroll
            for (int ai = 0; ai < 2; ++ai)
#pragma unroll
                for (int m = 0; m < 4; ++m) {
                    h16* rowp = gb + (size_t)(row0 + ai * 128 + m * 16) * 512 + jc0;
#pragma unroll
                    for (int bj = 0; bj < 2; ++bj) {
                        float v[8];
#pragma unroll
                        for (int e = 0; e < 4; ++e) { v[e] = acc[ai][bj][m][0][e]; v[4 + e] = acc[ai][bj][m][1][e]; }
                        if (g == 0) {
#pragma unroll
                            for (int e = 0; e < 8; ++e) v[e] = siluf_(v[e]) * 0.08838834764831845f;
                        } else if (g == 1) {
#pragma unroll
                            for (int e = 0; e < 8; ++e) { const float l = lbv[bj][e]; v[e] = logf(l + (1.f - l) * sigmoidf_(v[e])); }
                        } else if (g == 3) {
#pragma unroll
                            for (int e = 0; e < 8; ++e) v[e] = siluf_(v[e]);
                        } else if (g == 4) {
#pragma unroll
                            for (int e = 0; e < 8; ++e) v[e] *= 0.08838834764831845f;
                        }
                        u32x4 w; w.x = pk_f16(v[0], v[1]); w.y = pk_f16(v[2], v[3]); w.z = pk_f16(v[4], v[5]); w.w = pk_f16(v[6], v[7]);
                        *(u32x4*)(rowp + bj * 128) = w;
                    }
                }
        } else {
#pragma unroll
            for (int ai = 0; ai < 2; ++ai)
#pragma unroll
                for (int m = 0; m < 4; ++m) {
                    const int row = row0 + ai * 128 + m * 16;
                    const f32x4 v0 = acc[ai][0][m][0], v1 = acc[ai][0][m][1];
                    if (wc < 2) { float* p = IKRAW + (size_t)row * 64 + wc * 32 + 8 * fq; *(f32x4*)p = v0; *(f32x4*)(p + 4) = v1; }
                    else if (wc == 2 && fq == 0) { float* p = IW + (size_t)row * 8; *(f32x4*)p = v0 * 0.04419417382415922f; *(f32x4*)(p + 4) = v1 * 0.04419417382415922f; }
                }
        }
    }
};
struct EpiStoreF32 {
    static constexpr bool PERM = false, AFTER_DRAIN = false;
    float* Y; int ldc;
    __device__ __forceinline__ void operator()(const f32x4 (&acc)[2][2][4][2], const pg8::Unit& u, int wr, int wc, int fr, int fq) const {
        const int row0 = u.pm * 256 + wr * 64 + fr, col0 = u.pn * 256 + wc * 32 + 4 * fq;
#pragma unroll
        for (int ai = 0; ai < 2; ++ai)
#pragma unroll
            for (int m = 0; m < 4; ++m) {
                float* rowp = Y + (size_t)(row0 + ai * 128 + m * 16) * ldc + col0;
#pragma unroll
                for (int bj = 0; bj < 2; ++bj)
#pragma unroll
                    for (int n = 0; n < 2; ++n) *(f32x4*)(rowp + bj * 128 + n * 16) = acc[ai][bj][m][n];
            }
    }
};
struct EpiSwiGLU16 {
    static constexpr bool PERM = true, AFTER_DRAIN = false;
    h16* ACT;
    __device__ __forceinline__ void operator()(const f32x4 (&acc)[2][2][4][2], const pg8::Unit& u, int wr, int wc, int fr, int fq) const {
        const int row0 = u.pm * 256 + wr * 64 + fr, hc0 = u.pn * 128 + wc * 32 + 8 * fq;
#pragma unroll
        for (int ai = 0; ai < 2; ++ai)
#pragma unroll
            for (int m = 0; m < 4; ++m) {
                float v[8];
#pragma unroll
                for (int e = 0; e < 4; ++e) { v[e] = siluf_(acc[ai][0][m][0][e]) * acc[ai][1][m][0][e]; v[4 + e] = siluf_(acc[ai][0][m][1][e]) * acc[ai][1][m][1][e]; }
                u32x4 w; w.x = pk_f16(v[0], v[1]); w.y = pk_f16(v[2], v[3]); w.z = pk_f16(v[4], v[5]); w.w = pk_f16(v[6], v[7]);
                *(u32x4*)(ACT + (size_t)(row0 + ai * 128 + m * 16) * DFF + hc0) = w;
            }
    }
};

__device__ __forceinline__ void transpose_item(const float* __restrict__ W, int ldw, int src_col0, int valid, h16* __restrict__ WT, int K, int dst_row0, int k0, LAS float* scr, int lane) {
    const bool ok = (lane & 31) < valid;
#pragma unroll 8
    for (int i = 0; i < 32; ++i) { const int kk = 2 * i + (lane >> 5); scr[kk * 33 + (lane & 31)] = ok ? W[(size_t)(k0 + kk) * ldw + src_col0 + (lane & 31)] : 0.f; }
    asm volatile("s_waitcnt lgkmcnt(0)" ::: "memory");
    const int c = lane & 7;
#pragma unroll
    for (int j = 0; j < 4; ++j) { const int n = (lane >> 3) + 8 * j; const LAS float* s = scr + (8 * c) * 33 + n;
        u32x4 o; o.x = pk_f16(s[0 * 33], s[1 * 33]); o.y = pk_f16(s[2 * 33], s[3 * 33]); o.z = pk_f16(s[4 * 33], s[5 * 33]); o.w = pk_f16(s[6 * 33], s[7 * 33]);
        *(u32x4*)(WT + (size_t)(dst_row0 + n) * K + k0 + 8 * c) = o; }
    asm volatile("s_waitcnt lgkmcnt(0)" ::: "memory");
}

struct Args {
    const float* x; const float* c; const int* positions; const float* w_ada; const float* b_ada;
    const float* n_pre_mix; const float* n_post_mix; const float* n_pre_ffn; const float* n_post_ffn;
    const float* w_in; const float* lbraw; const float* onorm; const float* knw; const float* knb;
    const float* w_out; const float* w_ffn_in; const float* w_ffn_out;
    float* out; unsigned char* ws;
};

__device__ __forceinline__ void normmod_row(const float* __restrict__ xrow, const float* __restrict__ gain, const float* __restrict__ mb, int sc_off, int sh_off, h16* __restrict__ hrow, int lane) {
    const f32x4* xr = (const f32x4*)xrow;
    f32x4 v[4]; float ss = 0.f;
#pragma unroll
    for (int j = 0; j < 4; ++j) { v[j] = xr[lane + 64 * j]; ss += v[j].x * v[j].x + v[j].y * v[j].y + v[j].z * v[j].z + v[j].w * v[j].w; }
    const float r = rsqrtf(wave_sum(ss) * (1.f / D_) + EPS);
#pragma unroll
    for (int j = 0; j < 4; ++j) {
        const int col = (lane + 64 * j) * 4;
        const f32x4 g4 = *(const f32x4*)(gain + col), s4 = *(const f32x4*)(mb + sc_off + col), h4 = *(const f32x4*)(mb + sh_off + col);
        u32x2 w; w.x = pk_f16(v[j].x * r * g4.x * (1.f + s4.x) + h4.x, v[j].y * r * g4.y * (1.f + s4.y) + h4.y);
        w.y = pk_f16(v[j].z * r * g4.z * (1.f + s4.z) + h4.z, v[j].w * r * g4.w * (1.f + s4.w) + h4.w);
        *(u32x2*)(hrow + col) = w;
    }
}

template <bool NEXT>
__device__ __forceinline__ void post_row(const float* xin, const float* __restrict__ Yrow, const float* __restrict__ g_post, const float* __restrict__ mb, int gt_off,
                                         float* xout, const float* __restrict__ g_pre, int sc_off, int sh_off, h16* __restrict__ hrow, int lane) {
    const f32x4* yr = (const f32x4*)Yrow; const f32x4* xr = (const f32x4*)xin; f32x4* xo = (f32x4*)xout;
    f32x4 y[4], xv[4]; float ss = 0.f;
#pragma unroll
    for (int j = 0; j < 4; ++j) { y[j] = yr[lane + 64 * j]; xv[j] = xr[lane + 64 * j]; ss += y[j].x * y[j].x + y[j].y * y[j].y + y[j].z * y[j].z + y[j].w * y[j].w; }
    const float r = rsqrtf(wave_sum(ss) * (1.f / D_) + EPS);
    float s2 = 0.f;
#pragma unroll
    for (int j = 0; j < 4; ++j) {
        const int col = (lane + 64 * j) * 4;
        const f32x4 g4 = *(const f32x4*)(g_post + col), t4 = *(const f32x4*)(mb + gt_off + col);
        xv[j].x += t4.x * (y[j].x * r * g4.x); xv[j].y += t4.y * (y[j].y * r * g4.y); xv[j].z += t4.z * (y[j].z * r * g4.z); xv[j].w += t4.w * (y[j].w * r * g4.w);
        xo[lane + 64 * j] = xv[j];
        s2 += xv[j].x * xv[j].x + xv[j].y * xv[j].y + xv[j].z * xv[j].z + xv[j].w * xv[j].w;
    }
    if (NEXT) {
        const float r2 = rsqrtf(wave_sum(s2) * (1.f / D_) + EPS);
#pragma unroll
        for (int j = 0; j < 4; ++j) {
            const int col = (lane + 64 * j) * 4;
            const f32x4 g4 = *(const f32x4*)(g_pre + col), s4 = *(const f32x4*)(mb + sc_off + col), h4 = *(const f32x4*)(mb + sh_off + col);
            u32x2 w; w.x = pk_f16(xv[j].x * r2 * g4.x * (1.f + s4.x) + h4.x, xv[j].y * r2 * g4.y * (1.f + s4.y) + h4.y);
            w.y = pk_f16(xv[j].z * r2 * g4.z * (1.f + s4.z) + h4.z, xv[j].w * r2 * g4.w * (1.f + s4.w) + h4.w);
            *(u32x2*)(hrow + col) = w;
        }
    }
}

__device__ __forceinline__ void fixup_row(int m, const int* __restrict__ positions, h16* AQ, h16* AK, h16* IQ, const float* __restrict__ IKRAW, h16* __restrict__ IK,
                                          const float* __restrict__ knw, const float* __restrict__ knb, int lane) {
    const float pos = (float)positions[m];
    float s_, c_;
    { const float inv = lane < 16 ? c_inv16[lane] : c_inv8[lane & 7]; sincos_acc(pos * inv, s_, c_); }
    {
        const int h = lane >> 4, i = lane & 15;
        const float cs = __shfl(c_, i), sn = __shfl(s_, i);
        const size_t o = (size_t)m * 512 + h * 128 + i;
        { const float x1 = h2f(AQ[o]), x2 = h2f(AQ[o + 16]); AQ[o] = f2h(x1 * cs - x2 * sn); AQ[o + 16] = f2h(x2 * cs + x1 * sn); }
        { const float x1 = h2f(AK[o]), x2 = h2f(AK[o + 16]); AK[o] = f2h(x1 * cs - x2 * sn); AK[o + 16] = f2h(x2 * cs + x1 * sn); }
    }
    {
        const int h = lane >> 3, i = lane & 7;
        const float cs = __shfl(c_, 16 + i), sn = __shfl(s_, 16 + i);
        const size_t o = (size_t)m * 512 + h * 64 + i;
        const float x1 = h2f(IQ[o]), x2 = h2f(IQ[o + 8]); IQ[o] = f2h(x1 * cs - x2 * sn); IQ[o + 8] = f2h(x2 * cs + x1 * sn);
    }
    {
        const float v = IKRAW[(size_t)m * 64 + lane];
        const float mu = wave_sum(v) * (1.f / 64.f);
        const float d = v - mu;
        const float var = wave_sum(d * d) * (1.f / 64.f);
        float y = d * rsqrtf(var + EPS) * knw[lane] + knb[lane];
        const float other = __shfl_xor(y, 8);
        const float cs = __shfl(c_, 16 + (lane & 7)), sn = __shfl(s_, 16 + (lane & 7));
        if (lane < 8) y = y * cs - other * sn; else if (lane < 16) y = y * cs + other * sn;
        { const int sq = m & (T_ - 1), bb = m / T_; IK[(size_t)bb * T_ * 64 + (size_t)(sq >> 5) * 2048 + (((lane >> 4) * 2 + ((lane >> 3) & 1)) * 32 + (sq & 31)) * 8 + (lane & 7)] = f2h(y); }
    }
}

__device__ __forceinline__ void hgrn_naive_task(int task, const h16* __restrict__ QH, const h16* __restrict__ LF, const h16* __restrict__ V, float* __restrict__ OH, int lane) {
    const int bh = task >> 1, b = bh >> 2, h = bh & 3, j = (task & 1) * 64 + lane;
    float S[128];
#pragma unroll
    for (int k = 0; k < 128; ++k) S[k] = 0.f;
    for (int t = 0; t < T_; ++t) {
        const size_t row = (size_t)(b * T_ + t) * 512 + h * 128;
        const float v = h2f(V[row + j]);
        const float f0 = expf(h2f(LF[row + lane])), f1 = expf(h2f(LF[row + 64 + lane]));
        const float q0 = h2f(QH[row + lane]), q1 = h2f(QH[row + 64 + lane]);
        float o = 0.f;
#pragma unroll
        for (int k = 0; k < 64; ++k) {
            const float f = __int_as_float(__builtin_amdgcn_readlane(__float_as_int(f0), k)), q = __int_as_float(__builtin_amdgcn_readlane(__float_as_int(q0), k));
            S[k] = fmaf(f, S[k] - v, v); o = fmaf(q, S[k], o);
        }
#pragma unroll
        for (int k = 0; k < 64; ++k) {
            const float f = __int_as_float(__builtin_amdgcn_readlane(__float_as_int(f1), k)), q = __int_as_float(__builtin_amdgcn_readlane(__float_as_int(q1), k));
            S[64 + k] = fmaf(f, S[64 + k] - v, v); o = fmaf(q, S[64 + k], o);
        }
        OH[row + j] = o;
    }
}

__device__ __forceinline__ unsigned tokey(float f) { const unsigned u = __float_as_uint(f); return (u & 0x80000000u) ? ~u : (u | 0x80000000u); }
#define SCI(s) ((s) + ((s) >> 5))
__device__ __forceinline__ void dsa_query(int m, LAS unsigned char* lds, const h16* __restrict__ IQ, const h16* __restrict__ IK, const float* __restrict__ IW,
                                          unsigned long long* __restrict__ MASK) {
    LAS float* sc = (LAS float*)lds;
    LAS float* qi = (LAS float*)(lds + 33792);
    LAS float* wv = (LAS float*)(lds + 37888);
    LAS unsigned* hist = (LAS unsigned*)(lds + 37920);
    LAS int* sel = (LAS int*)(lds + 38944);
    LAS int* cnt_gt = (LAS int*)(lds + 39968);
    LAS int* cnt_eq = (LAS int*)(lds + 42016);
    LAS unsigned* shp = (LAS unsigned*)(lds + 48160);
    const int b = m / T_, t = m % T_, n = t + 1, tid = threadIdx.x;
    __syncthreads();
    qi[tid] = h2f(IQ[(size_t)m * 512 + tid]);
    if (tid < 8) wv[tid] = IW[(size_t)m * 8 + tid];
    __syncthreads();
    for (int s = tid; s < n; s += NTHR) {
        const u32x4* kr = (const u32x4*)(IK + (size_t)(b * T_ + s) * 64);
        float kf[64];
#pragma unroll
        for (int i = 0; i < 8; ++i) {
            const u32x4 u = kr[i];
            const unsigned w[4] = {u.x, u.y, u.z, u.w};
#pragma unroll
            for (int e = 0; e < 4; ++e) { kf[i * 8 + e * 2] = h2f((h16)(w[e] & 0xffff)); kf[i * 8 + e * 2 + 1] = h2f((h16)(w[e] >> 16)); }
        }
        float score = 0.f;
#pragma unroll
        for (int h = 0; h < 8; ++h) {
            float d = 0.f;
#pragma unroll
            for (int e = 0; e < 64; ++e) d = fmaf(qi[h * 64 + e], kf[e], d);
            score = fmaf(wv[h], fmaxf(d, 0.f), score);
        }
        if (score == 0.f) score = 0.f;
        sc[SCI(s)] = score;
    }
    __syncthreads();
    int nsel;
    if (n <= 256) {
        if (tid < n) sel[tid] = tid;
        nsel = n;
    } else {
        unsigned prefix = 0; int remaining = 256;
        for (int pass = 0; pass < 4; ++pass) {
            const int shift = 24 - 8 * pass;
            if (tid < 256) hist[tid] = 0u;
            __syncthreads();
            for (int i = 0; i < 16; ++i) {
                const int s = tid * 16 + i;
                if (s < n) {
                    const unsigned key = tokey(sc[SCI(s)]);
                    if (pass == 0 || (unsigned)((unsigned long long)key >> (shift + 8)) == prefix) __hip_atomic_fetch_add((unsigned*)(hist + ((key >> shift) & 255u)), 1u, __ATOMIC_RELAXED, __HIP_MEMORY_SCOPE_WORKGROUP);
                }
            }
            __syncthreads();
            if (tid == 0) {
                int cum = 0, bin = 255;
                for (; bin > 0; --bin) { const int c = (int)hist[bin]; if (cum + c >= remaining) break; cum += c; }
                shp[0] = (prefix << 8) | (unsigned)bin; shp[1] = (unsigned)(remaining - cum);
            }
            __syncthreads();
            prefix = shp[0]; remaining = (int)shp[1];
        }
        const unsigned thr = prefix;
        int cg = 0, ce = 0;
        for (int i = 0; i < 16; ++i) { const int s = tid * 16 + i; if (s < n) { const unsigned key = tokey(sc[SCI(s)]); cg += key > thr; ce += key == thr; } }
        cnt_gt[tid] = cg; cnt_eq[tid] = ce;
        __syncthreads();
        if (tid == 0) { int a = 0, e = 0; for (int i = 0; i < NTHR; ++i) { const int g0 = cnt_gt[i], e0 = cnt_eq[i]; cnt_gt[i] = a; cnt_eq[i] = e; a += g0; e += e0; } }
        __syncthreads();
        int pg = cnt_gt[tid], pe = cnt_eq[tid];
        const int ngt = 256 - remaining;
        for (int i = 0; i < 16; ++i) {
            const int s = tid * 16 + i;
            if (s < n) {
                const unsigned key = tokey(sc[SCI(s)]);
                if (key > thr) { if (pg < 256) sel[pg] = s; ++pg; }
                else if (key == thr) { if (pe < remaining) sel[ngt + pe] = s; ++pe; }
            }
        }
        nsel = 256;
    }
    __syncthreads();
    {
        LAS unsigned* mb = (LAS unsigned*)(lds + 44064);
        if (tid < 256) mb[tid] = 0u;
        __syncthreads();
        if (tid < nsel) { const int sidx = sel[tid]; __hip_atomic_fetch_or((unsigned*)(mb + (sidx >> 5)), 1u << (sidx & 31), __ATOMIC_RELAXED, __HIP_MEMORY_SCOPE_WORKGROUP); }
        __syncthreads();
        if (tid < 128) MASK[((size_t)(b * 128 + tid)) * 8192 + t] = (unsigned long long)mb[2 * tid] | ((unsigned long long)mb[2 * tid + 1] << 32);
    }
}

__global__ void __launch_bounds__(NTHR, 2) fwd_kernel(Args a) {
    extern __shared__ __attribute__((aligned(16))) unsigned char lds_raw[];
    LAS unsigned char* lds = (LAS unsigned char*)lds_raw;
    volatile LAS unsigned* MISC = (volatile LAS unsigned*)(lds + MISC_OFF);
    const int tid = threadIdx.x, lane = tid & 63, wave = __builtin_amdgcn_readfirstlane(tid >> 6);
    const int G = gridDim.x, bx = blockIdx.x;
    unsigned char* ws = a.ws;
    unsigned* ctl = (unsigned*)(ws + WS_CTL);
    for (int u = tid; u < (LDS_BYTES - LDSCTL_OFF) / 4; u += NTHR) ((LAS unsigned*)(lds + LDSCTL_OFF))[u] = 0u;
    __syncthreads();
    XcdBarrier bar = xcd_barrier_post(ctl + CW_BAR, MISC + 8);
#define GRID_BAR() xcd_barrier(bar)

    float* MOD = (float*)(ws + WS_MOD); float* LB = (float*)(ws + WS_LB);
    h16* WIN = (h16*)(ws + WS_WIN); h16* WOUT = (h16*)(ws + WS_WOUT); h16* WF1 = (h16*)(ws + WS_WF1); h16* WF2 = (h16*)(ws + WS_WF2);
    h16* XN = (h16*)(ws + WS_XN); h16* OM = XN;
    h16* GRP = (h16*)(ws + WS_GRP);
    h16* QH = GRP; h16* LF = (h16*)(ws + WS_GRP + GRP_STRIDE); h16* V = (h16*)(ws + WS_GRP + 2 * GRP_STRIDE); h16* Gt = (h16*)(ws + WS_GRP + 3 * GRP_STRIDE);
    h16* AQ = (h16*)(ws + WS_GRP + 4 * GRP_STRIDE); h16* AK = (h16*)(ws + WS_GRP + 5 * GRP_STRIDE); h16* AV = (h16*)(ws + WS_GRP + 6 * GRP_STRIDE); h16* IQ = (h16*)(ws + WS_GRP + 7 * GRP_STRIDE);
    h16* IK = (h16*)(ws + WS_IK); float* IW = (float*)(ws + WS_IW); float* IKRAW = (float*)(ws + WS_IKRAW);
    h16* UST = (h16*)(ws + WS_UST); float* DEC = (float*)(ws + WS_DEC); float* Y = (float*)(ws + WS_Y); h16* ACT = (h16*)(ws + WS_ACT);
    unsigned long long* MASK = (unsigned long long*)(ws + WS_MASK); h16* PART = (h16*)(ws + WS_PART); float* MLB = (float*)(ws + WS_ML);
    const int gw = bx * NWAVES + wave, NGW = G * NWAVES;

    {
        LAS float* scr = (LAS float*)(lds + wave * 16384);
        constexpr int I_IN = (DIN_PAD / 32) * (D_ / 64), I_OUT = (D_ / 32) * (D_ / 64), I_F1 = (2 * DFF / 32) * (D_ / 64), I_F2 = (D_ / 32) * (DFF / 64);
        for (int it = gw; it < I_IN + I_OUT + I_F1 + I_F2; it += NGW) {
            int r = it;
            if (r < I_IN) { const int rb = r / (D_ / 64), kb = r % (D_ / 64); const int valid = DIN - rb * 32; transpose_item(a.w_in, DIN, rb * 32, valid < 0 ? 0 : valid, WIN, D_, rb * 32, kb * 64, scr, lane); continue; } r -= I_IN;
            if (r < I_OUT) { const int rb = r / (D_ / 64), kb = r % (D_ / 64); transpose_item(a.w_out, D_, rb * 32, 32, WOUT, D_, rb * 32, kb * 64, scr, lane); continue; } r -= I_OUT;
            if (r < I_F1) { const int rb = r / (D_ / 64), kb = r % (D_ / 64); const int drow = rb * 32, pn = drow >> 8, bj = (drow >> 7) & 1, i0 = drow & 127;
                transpose_item(a.w_ffn_in, 2 * DFF, bj * DFF + pn * 128 + i0, 32, WF1, D_, drow, kb * 64, scr, lane); continue; } r -= I_F1;
            { const int rb = r / (DFF / 64), kb = r % (DFF / 64); transpose_item(a.w_ffn_out, D_, rb * 32, 32, WF2, DFF, rb * 32, kb * 64, scr, lane); }
        }
        __syncthreads();
        LAS float* scs = (LAS float*)lds;
        LAS float* part = (LAS float*)(lds + 8192);
        for (int i = tid; i < 2048; i += NTHR) scs[i] = siluf_(a.c[i]);
        __syncthreads();
        for (int cb = bx; cb < 256; cb += G) {
            const int rl = tid / 6, q = tid % 6;
            if (rl < 85) {
                f32x4 a0 = {0.f, 0.f, 0.f, 0.f}, a1 = {0.f, 0.f, 0.f, 0.f};
                for (int d = rl; d < 1024; d += 85) { const f32x4 w4 = *(const f32x4*)(a.w_ada + (size_t)d * 6144 + 24 * cb + 4 * q); a0 += w4 * scs[d]; a1 += w4 * scs[1024 + d]; }
#pragma unroll
                for (int e = 0; e < 4; ++e) { part[(rl * 2 + 0) * 24 + 4 * q + e] = a0[e]; part[(rl * 2 + 1) * 24 + 4 * q + e] = a1[e]; }
            }
            __syncthreads();
            if (tid < 48) { const int bb = tid / 24, col = tid % 24; float s = 0.f; for (int r2 = 0; r2 < 85; ++r2) s += part[(r2 * 2 + bb) * 24 + col]; MOD[bb * 6144 + 24 * cb + col] = s + a.b_ada[24 * cb + col]; }
            __syncthreads();
        }
        if (bx == 0) for (int i = tid; i < 512; i += NTHR) LB[i] = 1.f / (1.f + expf(a.lbraw[512 + i] - a.lbraw[i]));
    }
    GRID_BAR();
    for (int m = gw; m < M_; m += NGW) normmod_row(a.x + (size_t)m * D_, a.n_pre_mix, MOD + (m / T_) * 6144, 1024, 0, XN + (size_t)m * D_, lane);
    GRID_BAR();
    {
        pg8::Gemm g{XN, WIN, M_, DIN_PAD, D_}; pg8::StaticOrder S; S.init(M_, DIN_PAD, G, bx);
        EpiIn16 E{GRP, IKRAW, IW, LB};
        pg8::gemm_phase<EpiIn16, pg8::StaticOrder, true, true>(lds, g, S, E);
    }
    GRID_BAR();
    for (int m = gw; m < M_; m += NGW) fixup_row(m, a.positions, AQ, AK, IQ, IKRAW, IK, a.knw, a.knb, lane);
    GRID_BAR();
    for (int task = bx; task < 1024; task += G) hg::h1_task(task, lds, LF, V, UST, DEC);
    for (int task = gw; task < 2048; task += NGW) idx::select_task(task, lds + wave * idx::WAVE_LDS, IQ, IK, IW, (unsigned*)MASK, lane);
    GRID_BAR();
    hg::h2_scan(bx * NTHR + tid, G * NTHR, UST, DEC);
    for (int v = bx; v < 256; v += G) {
        const int bh = v & 7, slot = v >> 3, b = bh >> 2, h = bh & 3;
        att::BlockRef ur[2]; bool has1 = false;
#pragma unroll
        for (int j = 0; j < 2; ++j) {
            const int qb = c_att_tab[slot][j][0], jlo = c_att_tab[slot][j][1], nt = c_att_tab[slot][j][2], seg = c_att_tab[slot][j][3];
            const int qbc = qb < 0 ? 0 : qb;
            ur[j].Q = AQ + ((size_t)(b * T_ + qbc * 256)) * 512 + h * 128; ur[j].K = AK + (size_t)b * T_ * 512 + h * 128; ur[j].V = AV + (size_t)b * T_ * 512 + h * 128;
            ur[j].MK = MASK + ((size_t)(b * T_ + qbc * 256)) * 128; ur[j].P0 = qbc * 256; ur[j].jlo = jlo; ur[j].nt = nt;
            const int pidx = bh * 24 + (qbc - 8);
            if (seg == 1) { ur[j].O = PART + (size_t)pidx * (256 * 128); ur[j].ldo = 128; }
            else { ur[j].O = OM + ((size_t)(b * T_ + qbc * 256)) * 1024 + 512 + h * 128; ur[j].ldo = 1024; }
            ur[j].ML = seg >= 0 ? MLB + ((size_t)(pidx * 2 + seg)) * 512 : nullptr;
            if (j == 1) has1 = qb >= 0;
        }
        att::Seam S;
        att::prime(ur[0], (char*)lds_raw, S);
        att::block(ur[0], has1 ? ur[1] : ur[0], (char*)lds_raw, S);
        if (has1) att::block(ur[1], ur[1], (char*)lds_raw, S);
    }
    GRID_BAR();
    for (int task = bx; task < 1024; task += G) hg::h3_task(task, lds, QH, LF, V, Gt, UST, a.onorm, OM);
    for (int rid = gw; rid < 192 * 256; rid += NGW) {
        const int pidx = rid >> 8, row = rid & 255, bh = pidx / 24, qb = 8 + pidx % 24, b = bh >> 2, h = bh & 3;
        const float* ml = MLB + (size_t)(pidx * 2) * 512 + row * 2;
        const float mA = ml[0], lA = ml[1], mB = ml[512], lB = ml[513], mm = fmaxf(mA, mB);
        const float wA = lA * __builtin_amdgcn_exp2f((mA - mm) * 1.4426950408889634f), wB = lB * __builtin_amdgcn_exp2f((mB - mm) * 1.4426950408889634f), inv = 1.f / (wA + wB);
        h16* op = OM + ((size_t)(b * T_ + qb * 256 + row)) * 1024 + 512 + h * 128 + 2 * lane;
        const unsigned ua = *(const unsigned*)op, ub = *(const unsigned*)(PART + (size_t)pidx * (256 * 128) + row * 128 + 2 * lane);
        const float o0 = (h2f((h16)(ua & 0xffff)) * wA + h2f((h16)(ub & 0xffff)) * wB) * inv, o1 = (h2f((h16)(ua >> 16)) * wA + h2f((h16)(ub >> 16)) * wB) * inv;
        *(unsigned*)op = pk_f16(o0, o1);
    }
    GRID_BAR();
    {
        pg8::Gemm g{OM, WOUT, M_, D_, D_}; pg8::StaticOrder S; S.init(M_, D_, G, bx);
        EpiStoreF32 E{Y, D_};
        pg8::gemm_phase<EpiStoreF32, pg8::StaticOrder, true, true>(lds, g, S, E);
    }
    GRID_BAR();
    for (int m = gw; m < M_; m += NGW)
        post_row<true>(a.x + (size_t)m * D_, Y + (size_t)m * D_, a.n_post_mix, MOD + (m / T_) * 6144, 2048, a.out + (size_t)m * D_, a.n_pre_ffn, 4096, 3072, XN + (size_t)m * D_, lane);
    GRID_BAR();
    {
        pg8::Gemm g{XN, WF1, M_, 2 * DFF, D_}; pg8::StaticOrder S; S.init(M_, 2 * DFF, G, bx);
        EpiSwiGLU16 E{ACT};
        pg8::gemm_phase<EpiSwiGLU16, pg8::StaticOrder, true, true>(lds, g, S, E);
    }
    GRID_BAR();
    {
        pg8::Gemm g{ACT, WF2, M_, D_, DFF}; pg8::StaticOrder S; S.init(M_, D_, G, bx);
        EpiStoreF32 E{Y, D_};
        pg8::gemm_phase<EpiStoreF32, pg8::StaticOrder, true, true>(lds, g, S, E);
    }
    GRID_BAR();
    for (int m = gw; m < M_; m += NGW)
        post_row<false>(a.out + (size_t)m * D_, Y + (size_t)m * D_, a.n_post_ffn, MOD + (m / T_) * 6144, 5120, a.out + (size_t)m * D_, nullptr, 0, 0, nullptr, lane);
}
}

extern "C" void kernel_launch(void* const* d_in, const int* in_sizes, int n_in, void* d_out, int out_size, void* d_ws, size_t ws_size, hipStream_t stream) {
    static int grid = 0;
    if (grid == 0) {
        if (n_in != 17 || in_sizes[0] != M_ * D_ || out_size != M_ * D_ || ws_size < WS_END) { fprintf(stderr, "kernel_launch: unexpected problem (n_in %d, ws %zu); nothing launched\n", n_in, ws_size); grid = -1; return; }
        int dev = 0, cus = 0, per_cu = 0;
        if (hipGetDevice(&dev) != hipSuccess || hipDeviceGetAttribute(&cus, hipDeviceAttributeMultiprocessorCount, dev) != hipSuccess) { grid = -1; return; }
        if (hipFuncSetAttribute((const void*)fwd_kernel, hipFuncAttributeMaxDynamicSharedMemorySize, LDS_BYTES) != hipSuccess) { fprintf(stderr, "kernel_launch: hipFuncSetAttribute failed\n"); grid = -1; return; }
        if (hipOccupancyMaxActiveBlocksPerMultiprocessor(&per_cu, (const void*)fwd_kernel, NTHR, LDS_BYTES) != hipSuccess || per_cu < 1) fprintf(stderr, "kernel_launch: occupancy query reports %d\n", per_cu);
        (void)hipGetLastError();
        grid = cus;
        if (grid != 256) fprintf(stderr, "kernel_launch: %d CUs (expected 256)\n", grid);
    }
    if (grid < 0) return;
    if (hipMemsetAsync((char*)d_ws + WS_CTL, 0, CTL_ZERO_BYTES, stream) != hipSuccess) return;
    Args a{};
    a.x = (const float*)d_in[0]; a.c = (const float*)d_in[1]; a.positions = (const int*)d_in[2]; a.w_ada = (const float*)d_in[3]; a.b_ada = (const float*)d_in[4];
    a.n_pre_mix = (const float*)d_in[5]; a.n_post_mix = (const float*)d_in[6]; a.n_pre_ffn = (const float*)d_in[7]; a.n_post_ffn = (const float*)d_in[8];
    a.w_in = (const float*)d_in[9]; a.lbraw = (const float*)d_in[10]; a.onorm = (const float*)d_in[11]; a.knw = (const float*)d_in[12]; a.knb = (const float*)d_in[13];
    a.w_out = (const float*)d_in[14]; a.w_ffn_in = (const float*)d_in[15]; a.w_ffn_out = (const float*)d_in[16];
    a.out = (float*)d_out; a.ws = (unsigned char*)d_ws;
    hipLaunchKernelGGL(fwd_kernel, dim3(grid), dim3(NTHR), LDS_BYTES, stream, a);
}
```
